# Optimizing an MI355X kernel written in HIP

```python
import jax, jax.numpy as jnp
from jax import lax
import numpy as np

D_MODEL = 1024
BATCH = 16
SEQ = 2048
DEPTH = 2

HEAD_DIM = 64
GROUP_HEADS = 4
GROUP_WIDTH = GROUP_HEADS * HEAD_DIM
N_GROUPS = 4
D_MIX = N_GROUPS * GROUP_WIDTH
SB_COLS = 3 * GROUP_WIDTH
CONF_COLS = 2 * GROUP_WIDTH
GMLP_COLS = 2 * GROUP_WIDTH
LRU_COLS = 2 * GROUP_WIDTH
IN_COLS = SB_COLS + CONF_COLS + GMLP_COLS + LRU_COLS
SB_BLOCK = 128
CONF_KERNEL = 31
GMLP_CHUNK = 128
LRU_CONV = 4
LRU_C = 8.0
D_FF = 2816
N_EXPERTS = 8
TOP_K = 2
D_FF_EXPERT = 3584
EXPERT_BLOCK = 512
N_DENSE = (DEPTH + 1) // 2
N_MOE = DEPTH // 2
EPS = 1e-6

kernel_name = "hybrid_sb_conformer_gmlp_rglru_moe"


def rms_norm(x, g):
    xf = x.astype(jnp.float32)
    y = xf * lax.rsqrt(jnp.mean(xf * xf, axis=-1, keepdims=True) + EPS)
    return (y * g.astype(jnp.float32)).astype(x.dtype)


def layer_norm(x, g, b):
    xf = x.astype(jnp.float32)
    xc = xf - jnp.mean(xf, axis=-1, keepdims=True)
    var = jnp.mean(xc * xc, axis=-1, keepdims=True)
    return (xc * lax.rsqrt(var + EPS) * g.astype(jnp.float32) + b.astype(jnp.float32)).astype(x.dtype)


def causal_depthwise_conv(x, w, b):
    K, C = w.shape
    y = lax.conv_general_dilated(
        x, w[:, None, :], window_strides=(1,), padding=[(K - 1, 0)],
        dimension_numbers=("NWC", "WIO", "NWC"), feature_group_count=C)
    return y + b


def stick_breaking_attention(q, k, v):
    B, S, H, Dh = q.shape
    nb = S // SB_BLOCK
    scale = Dh ** -0.5
    kf = k.astype(jnp.float32)
    vf = v.astype(jnp.float32)
    qb = q.astype(jnp.float32).reshape(B, nb, SB_BLOCK, H, Dh).transpose(1, 0, 2, 3, 4)
    key_pos = jnp.arange(S)

    def block(args):
        q_blk, start = args
        z = jnp.einsum("bthd,bshd->bhts", q_blk, kf) * scale
        q_pos = start + jnp.arange(SB_BLOCK)
        mask = key_pos[None, :] < q_pos[:, None]
        log_beta = jax.nn.log_sigmoid(z)
        log_keep = jnp.where(mask, -jax.nn.softplus(z), 0.0)
        later = lax.cumsum(log_keep, axis=3, reverse=True) - log_keep
        w = jnp.where(mask, jnp.exp(log_beta + later), 0.0)
        return jnp.einsum("bhts,bshd->bthd", w, vf)

    out = lax.map(block, (qb, jnp.arange(nb, dtype=jnp.int32) * SB_BLOCK))
    return out.transpose(1, 0, 2, 3, 4).reshape(B, S, H * Dh).astype(q.dtype)


def conformer_conv(val, gate, w_dw, b_dw, ln_g, ln_b):
    h = val * jax.nn.sigmoid(gate)
    h = causal_depthwise_conv(h, w_dw, b_dw)
    h = layer_norm(h, ln_g, ln_b)
    return jax.nn.silu(h)


def chunked_spatial_gating(uv, ln_g, ln_b, w_s, b_s):
    B, S, _ = uv.shape
    u, v = jnp.split(jax.nn.gelu(uv), 2, axis=-1)
    v = layer_norm(v, ln_g, ln_b)
    nc = S // GMLP_CHUNK
    v = v.reshape(B, nc, GMLP_CHUNK, GROUP_HEADS, HEAD_DIM)
    tri = jnp.tril(jnp.ones((GMLP_CHUNK, GMLP_CHUNK), dtype=bool))
    w = jnp.where(tri, w_s, 0.0)
    mixed = jnp.einsum("hts,bcshd->bcthd", w, v) + b_s.T[:, :, None]
    return u * mixed.reshape(B, S, GROUP_WIDTH)


def rg_lru_branch(xb, gate, conv_w, conv_b, w_a, b_a, w_x, b_x, lam):
    xb = causal_depthwise_conv(xb, conv_w, conv_b)
    B, S, C = xb.shape
    xh = xb.reshape(B, S, GROUP_HEADS, HEAD_DIM)
    r = jax.nn.sigmoid(jnp.einsum("bshi,hij->bshj", xh, w_a).reshape(B, S, C) + b_a)
    i = jax.nn.sigmoid(jnp.einsum("bshi,hij->bshj", xh, w_x).reshape(B, S, C) + b_x)
    log_a = -LRU_C * r.astype(jnp.float32) * jax.nn.softplus(-lam.astype(jnp.float32))
    a = jnp.exp(log_a)
    b_in = jnp.sqrt(-jnp.expm1(2.0 * log_a)) * (i * xb).astype(jnp.float32)

    def combine(left, right):
        a1, b1 = left
        a2, b2 = right
        return a1 * a2, a2 * b1 + b2

    _, h = lax.associative_scan(combine, (a, b_in), axis=1)
    return (h * jax.nn.gelu(gate.astype(jnp.float32))).astype(xb.dtype)


def hybrid_mixer(h, w_in, q_norm_g, k_norm_g, conf_dw_w, conf_dw_b, conf_ln_g, conf_ln_b,
                 gmlp_ln_g, gmlp_ln_b, gmlp_ws, gmlp_bs, lru_conv_w, lru_conv_b,
                 lru_wa, lru_ba, lru_wx, lru_bx, lru_lambda, group_norm_g, w_out):
    B, S, _ = h.shape
    proj = jnp.einsum("bsd,dc->bsc", h, w_in)
    c1 = SB_COLS
    c2 = c1 + CONF_COLS
    c3 = c2 + GMLP_COLS
    sb, conf, gm, lru = jnp.split(proj, [c1, c2, c3], axis=-1)
    q, k, v = jnp.split(sb, 3, axis=-1)
    q = rms_norm(q.reshape(B, S, GROUP_HEADS, HEAD_DIM), q_norm_g)
    k = rms_norm(k.reshape(B, S, GROUP_HEADS, HEAD_DIM), k_norm_g)
    v = v.reshape(B, S, GROUP_HEADS, HEAD_DIM)
    y_a = stick_breaking_attention(q, k, v)
    conf_val, conf_gate = jnp.split(conf, 2, axis=-1)
    y_b = conformer_conv(conf_val, conf_gate, conf_dw_w, conf_dw_b, conf_ln_g, conf_ln_b)
    y_c = chunked_spatial_gating(gm, gmlp_ln_g, gmlp_ln_b, gmlp_ws, gmlp_bs)
    lru_x, lru_gate = jnp.split(lru, 2, axis=-1)
    y_d = rg_lru_branch(lru_x, lru_gate, lru_conv_w, lru_conv_b, lru_wa, lru_ba, lru_wx, lru_bx, lru_lambda)
    y = jnp.stack([y_a, y_b, y_c, y_d], axis=2)
    y = rms_norm(y, group_norm_g.reshape(N_GROUPS, GROUP_WIDTH)).reshape(B, S, D_MIX)
    return jnp.einsum("bsc,cd->bsd", y, w_out)


def swiglu(h, wg, wu, wd):
    return (jax.nn.silu(h @ wg) * (h @ wu)) @ wd


def top2_moe(h, router, wg, wu, wd):
    B, S, D = h.shape
    N = B * S
    A = N * TOP_K
    hf = h.reshape(N, D)
    logits = (hf @ router).astype(jnp.float32)
    top_logits, top_idx = lax.top_k(logits, TOP_K)
    gates = jax.nn.softmax(top_logits, axis=-1).astype(h.dtype)
    exp_ids = top_idx.reshape(A)
    tok_ids = jnp.repeat(jnp.arange(N, dtype=jnp.int32), TOP_K)
    gate_flat = gates.reshape(A)
    order = jnp.argsort(exp_ids)
    exp_sorted = exp_ids[order]
    tok_sorted = tok_ids[order]
    gate_sorted = gate_flat[order]
    counts = jnp.bincount(exp_ids, length=N_EXPERTS)
    starts = jnp.cumsum(counts) - counts
    padded = (counts + EXPERT_BLOCK - 1) // EXPERT_BLOCK * EXPERT_BLOCK
    pad_ends = jnp.cumsum(padded)
    pad_starts = pad_ends - padded
    rank = jnp.arange(A, dtype=jnp.int32) - starts[exp_sorted]
    dest = pad_starts[exp_sorted] + rank
    n_blocks = -(-A // EXPERT_BLOCK) + N_EXPERTS
    n_rows = n_blocks * EXPERT_BLOCK
    row_tok = jnp.full((n_rows,), N, dtype=jnp.int32).at[dest].set(tok_sorted)
    row_gate = jnp.zeros((n_rows,), h.dtype).at[dest].set(gate_sorted)
    block_start = jnp.arange(n_blocks, dtype=jnp.int32) * EXPERT_BLOCK
    block_exp = jnp.minimum(jnp.searchsorted(pad_ends, block_start, side="right"), N_EXPERTS - 1)
    h_pad = jnp.concatenate([hf, jnp.zeros((1, D), hf.dtype)], axis=0)

    def expert_block(args):
        tok, gate, e = args
        y = swiglu(h_pad[tok], wg[e], wu[e], wd[e])
        return y * gate[:, None]

    ys = lax.map(expert_block, (row_tok.reshape(n_blocks, EXPERT_BLOCK),
                                row_gate.reshape(n_blocks, EXPERT_BLOCK), block_exp))
    out = jnp.zeros((N + 1, D), h.dtype).at[row_tok].add(ys.reshape(n_rows, D))
    return out[:N].reshape(B, S, D)


def setup_inputs(seed: int = 0) -> dict:
    key = jax.random.key(seed)
    ks = jax.random.split(key, 40)
    f32 = jnp.float32

    def nrm(k, shape, scale):
        return jax.random.normal(k, shape, f32) * scale

    def gain(k, shape):
        return 1.0 + 0.02 * jax.random.normal(k, shape, f32)

    def bias(k, shape):
        return 0.02 * jax.random.normal(k, shape, f32)

    u = jax.random.uniform(ks[20], (DEPTH, GROUP_WIDTH), f32, minval=0.9, maxval=0.999)
    s = u ** (1.0 / LRU_C)
    lru_lambda = jnp.log(s) - jnp.log1p(-s)
    return {
        "x": jax.random.normal(ks[0], (BATCH, SEQ, D_MODEL), f32),
        "norm1_g": gain(ks[1], (DEPTH, D_MODEL)),
        "w_in": nrm(ks[2], (DEPTH, D_MODEL, IN_COLS), D_MODEL ** -0.5),
        "q_norm_g": gain(ks[3], (DEPTH, HEAD_DIM)),
        "k_norm_g": gain(ks[4], (DEPTH, HEAD_DIM)),
        "conf_dw_w": nrm(ks[5], (DEPTH, CONF_KERNEL, GROUP_WIDTH), CONF_KERNEL ** -0.5),
        "conf_dw_b": bias(ks[6], (DEPTH, GROUP_WIDTH)),
        "conf_ln_g": gain(ks[7], (DEPTH, GROUP_WIDTH)),
        "conf_ln_b": bias(ks[8], (DEPTH, GROUP_WIDTH)),
        "gmlp_ln_g": gain(ks[9], (DEPTH, GROUP_WIDTH)),
        "gmlp_ln_b": bias(ks[10], (DEPTH, GROUP_WIDTH)),
        "gmlp_ws": nrm(ks[11], (DEPTH, GROUP_HEADS, GMLP_CHUNK, GMLP_CHUNK), GMLP_CHUNK ** -0.5),
        "gmlp_bs": gain(ks[12], (DEPTH, GROUP_HEADS, GMLP_CHUNK)),
        "lru_conv_w": nrm(ks[13], (DEPTH, LRU_CONV, GROUP_WIDTH), LRU_CONV ** -0.5),
        "lru_conv_b": bias(ks[14], (DEPTH, GROUP_WIDTH)),
        "lru_wa": nrm(ks[15], (DEPTH, GROUP_HEADS, HEAD_DIM, HEAD_DIM), HEAD_DIM ** -0.5),
        "lru_ba": bias(ks[16], (DEPTH, GROUP_WIDTH)),
        "lru_wx": nrm(ks[17], (DEPTH, GROUP_HEADS, HEAD_DIM, HEAD_DIM), HEAD_DIM ** -0.5),
        "lru_bx": bias(ks[18], (DEPTH, GROUP_WIDTH)),
        "lru_lambda": lru_lambda,
        "group_norm_g": gain(ks[21], (DEPTH, D_MIX)),
        "w_out": nrm(ks[22], (DEPTH, D_MIX, D_MODEL), D_MIX ** -0.5),
        "norm2_g": gain(ks[23], (DEPTH, D_MODEL)),
        "ffn_w_gate": nrm(ks[24], (N_DENSE, D_MODEL, D_FF), D_MODEL ** -0.5),
        "ffn_w_up": nrm(ks[25], (N_DENSE, D_MODEL, D_FF), D_MODEL ** -0.5),
        "ffn_w_down": nrm(ks[26], (N_DENSE, D_FF, D_MODEL), D_FF ** -0.5),
        "moe_router": nrm(ks[27], (N_MOE, D_MODEL, N_EXPERTS), D_MODEL ** -0.5),
        "moe_w_gate": nrm(ks[28], (N_MOE, N_EXPERTS, D_MODEL, D_FF_EXPERT), D_MODEL ** -0.5),
        "moe_w_up": nrm(ks[29], (N_MOE, N_EXPERTS, D_MODEL, D_FF_EXPERT), D_MODEL ** -0.5),
        "moe_w_down": nrm(ks[30], (N_MOE, N_EXPERTS, D_FF_EXPERT, D_MODEL), D_FF_EXPERT ** -0.5),
    }


def reference(x, norm1_g, w_in, q_norm_g, k_norm_g, conf_dw_w, conf_dw_b, conf_ln_g, conf_ln_b,
              gmlp_ln_g, gmlp_ln_b, gmlp_ws, gmlp_bs, lru_conv_w, lru_conv_b, lru_wa, lru_ba,
              lru_wx, lru_bx, lru_lambda, group_norm_g, w_out, norm2_g,
              ffn_w_gate, ffn_w_up, ffn_w_down, moe_router, moe_w_gate, moe_w_up, moe_w_down):
    for l in range(DEPTH):
        h = rms_norm(x, norm1_g[l])
        x = x + hybrid_mixer(h, w_in[l], q_norm_g[l], k_norm_g[l], conf_dw_w[l], conf_dw_b[l],
                             conf_ln_g[l], conf_ln_b[l], gmlp_ln_g[l], gmlp_ln_b[l], gmlp_ws[l],
                             gmlp_bs[l], lru_conv_w[l], lru_conv_b[l], lru_wa[l], lru_ba[l],
                             lru_wx[l], lru_bx[l], lru_lambda[l], group_norm_g[l], w_out[l])
        h = rms_norm(x, norm2_g[l])
        if l % 2 == 0:
            j = l // 2
            x = x + swiglu(h, ffn_w_gate[j], ffn_w_up[j], ffn_w_down[j])
        else:
            j = l // 2
            x = x + top2_moe(h, moe_router[j], moe_w_gate[j], moe_w_up[j], moe_w_down[j])
    return x
```

```cpp
#include <hip/hip_runtime.h>
#include <cstdio>
#include <cstdint>

#ifndef MK_MULTI
#define MK_MULTI 0
#endif
#ifndef I8_INPROJ
#define I8_INPROJ 0
#endif
static_assert(!I8_INPROJ, "the prologue no longer builds XQ / RS for an int8 in-proj");
#ifndef I8_OUTPROJ
#define I8_OUTPROJ 0
#endif
#ifndef I8_FFN1
#define I8_FFN1 1
#endif
#ifndef F8_FFN2
#define F8_FFN2 1
#endif
#ifndef PROBE_MASK
#define PROBE_MASK 0
#endif

#define GAS __attribute__((address_space(1)))
#define LAS __attribute__((address_space(3)))
typedef unsigned short bf16;
typedef short bf16x8 __attribute__((ext_vector_type(8)));
typedef float f32x4 __attribute__((ext_vector_type(4)));
typedef float f32x2 __attribute__((ext_vector_type(2)));
typedef float f32x16 __attribute__((ext_vector_type(16)));
typedef unsigned u32x4 __attribute__((ext_vector_type(4)));
typedef unsigned u32x2 __attribute__((ext_vector_type(2)));
typedef GAS unsigned gu32;

constexpr int D = 1024, BATCH = 16, SEQ = 2048, NTOK = BATCH * SEQ, INC = 2304, DFF = 2816, NE = 8, DFE = 3584;
constexpr float EPS = 1e-6f, LOG2E = 1.4426950408889634f;
constexpr int C_Q = 0, C_K = 256, C_V = 512, C_CV = 768, C_CG = 1024, C_GU = 1280, C_GV = 1536, C_LX = 1792, C_LG = 2048;

constexpr size_t MiB = 1u << 20, KiB = 1u << 10;
constexpr size_t WS_CTL = 0, CTL_ZERO_BYTES = 1 * MiB;
constexpr size_t WS_WIN = 1 * MiB;
constexpr size_t WS_WOUT = 10 * MiB;
constexpr size_t WS_WGU = 14 * MiB;
constexpr size_t WS_WD = 25 * MiB;
constexpr size_t WS_GWM = 30 * MiB + 512 * KiB;
constexpr size_t WS_WAT = WS_GWM + 262144;
constexpr size_t WS_WXT = WS_WAT + 65536;
constexpr size_t WS_MGU8 = 31 * MiB;
constexpr size_t WS_MD8 = 87 * MiB;
constexpr size_t WS_XN8 = 115 * MiB;
constexpr size_t WS_XQ = WS_XN8;
constexpr size_t WS_XG8 = 147 * MiB + 256 * KiB;
constexpr size_t WS_YQ = WS_XG8;
constexpr size_t WS_LTOK = 215 * MiB + 256 * KiB;
constexpr size_t WS_LGATE = WS_LTOK + 2 * MiB;
constexpr size_t WS_SS = WS_LGATE + 2 * MiB;
constexpr size_t WS_RS = 512 * KiB;
constexpr size_t WS_RD = 768 * KiB;
constexpr size_t WS_YS = 640 * KiB;
constexpr size_t WS_PROJ = 221 * MiB + 256 * KiB;
constexpr size_t WS_Y = WS_PROJ + 144 * MiB;
constexpr size_t WS_HID = WS_PROJ;
constexpr size_t WS_XB = WS_PROJ + 238 * MiB;
constexpr size_t WS_END = WS_XB + 64 * MiB;
constexpr int SC_XN8 = 4, SC_WGU8 = 4, SC_HID8 = 4, SC_WD8 = 4;

constexpr int CW_TMO = 0;
constexpr int CW_BAR = 4096;
constexpr int CW_MOECNT = 16384;
constexpr int CW_WMAX = 20480;

constexpr int NWAVES = 8;
constexpr int LDS_BYTES = 147456;
constexpr int LDSCTL_OFF = 146944;
constexpr int MOE_TAB = LDSCTL_OFF + 64;

#define RLX_AGENT __ATOMIC_RELAXED, __HIP_MEMORY_SCOPE_AGENT
#define LDS_WAIT() asm volatile("s_waitcnt lgkmcnt(0)" ::: "memory")
#define VM_WAIT() asm volatile("s_waitcnt vmcnt(0)" ::: "memory")
__device__ __forceinline__ int lane_id() { int l; asm volatile("v_mbcnt_lo_u32_b32 %0, -1, 0\n\tv_mbcnt_hi_u32_b32 %0, -1, %0" : "=v"(l)); return l; }
#define OPAQUE_U(x) asm volatile("" : "+s"(x))
#define OPAQUE_TID() int wave_ = wv; asm volatile("" : "+s"(wave_)); int tid = wave_ * 64 + lane_id(); asm volatile("" : "+v"(tid)); const int lane = tid & 63, wave = wave_; (void)lane; (void)wave

__device__ __forceinline__ float bf_lo(unsigned w) { return __uint_as_float(w << 16); }
__device__ __forceinline__ float bf_hi(unsigned w) { return __uint_as_float(w & 0xffff0000u); }
typedef __bf16 bf16x2_t __attribute__((ext_vector_type(2)));
__device__ __forceinline__ unsigned pk2(float lo, float hi) { f32x2 v = {lo, hi}; bf16x2_t b = __builtin_convertvector(v, bf16x2_t); return __builtin_bit_cast(unsigned, b); }
__device__ __forceinline__ unsigned pk4_fp8(float a, float b, float c, float d) {
    a = __builtin_amdgcn_fmed3f(a, -448.f, 448.f); b = __builtin_amdgcn_fmed3f(b, -448.f, 448.f); c = __builtin_amdgcn_fmed3f(c, -448.f, 448.f); d = __builtin_amdgcn_fmed3f(d, -448.f, 448.f);
    int v = 0; v = __builtin_amdgcn_cvt_pk_fp8_f32(a, b, v, false); v = __builtin_amdgcn_cvt_pk_fp8_f32(c, d, v, true); return (unsigned)v; }
template <int CTRL> __device__ __forceinline__ float dppf(float v) { return __int_as_float(__builtin_amdgcn_update_dpp(0, __float_as_int(v), CTRL, 0xf, 0xf, true)); }
template <int M> __device__ __forceinline__ float swz_xor(float v) { static_assert(M == 1 || M == 2 || M == 4 || M == 8, "M"); return dppf<M == 1 ? 0xB1 : M == 2 ? 0x4E : M == 4 ? 0x141 : 0x128>(v); }
__device__ __forceinline__ void rows16(float v, float& a, float& b) { auto r = __builtin_amdgcn_permlane16_swap(__float_as_uint(v), __float_as_uint(v), false, false); a = __uint_as_float(r[0]); b = __uint_as_float(r[1]); }
__device__ __forceinline__ float sum_rows16(float v) { float a, b; rows16(v, a, b); return a + b; }
__device__ __forceinline__ void halves(float v, float& lo, float& hi) { auto r = __builtin_amdgcn_permlane32_swap(__float_as_uint(v), __float_as_uint(v), false, false); lo = __uint_as_float(r[0]); hi = __uint_as_float(r[1]); }
__device__ __forceinline__ float sum_halves(float v) { float lo, hi; halves(v, lo, hi); return lo + hi; }
__device__ __forceinline__ unsigned pk4_i8(float a, float b, float c, float d) {
    const int q0 = __float2int_rn(a), q1 = __float2int_rn(b), q2 = __float2int_rn(c), q3 = __float2int_rn(d);
    return (unsigned)(q0 & 255) | ((unsigned)(q1 & 255) << 8) | ((unsigned)(q2 & 255) << 16) | ((unsigned)q3 << 24); }
__device__ __forceinline__ float wave_max(float v);
__device__ __forceinline__ float wave_sum(float v) {
    v += swz_xor<1>(v); v += swz_xor<2>(v); v += swz_xor<4>(v); v += swz_xor<8>(v); v = sum_rows16(v);
    return sum_halves(v);
}
__device__ __forceinline__ float one_minus_exp(float y) {
    const float ser = -y * (1.f + y * (0.5f + y * (0.16666667f + y * (0.041666668f + y * (0.008333334f + y * 0.0013888889f)))));
    const float dir = 1.f - __builtin_amdgcn_exp2f(y * LOG2E);
    return y > -0.25f ? ser : dir;
}
__device__ __forceinline__ float fast_sigmoid(float x) { return __builtin_amdgcn_rcpf(1.0f + __builtin_amdgcn_exp2f(-x * LOG2E)); }
__device__ __forceinline__ float gelu_tanh(float x) { const float u = x + 0.044715f * x * x * x; return x * __builtin_amdgcn_rcpf(1.0f + __builtin_amdgcn_exp2f(-2.0f * 0.7978845608f * LOG2E * u)); }

__device__ __forceinline__ float wave_max(float v) {
    v = fmaxf(v, swz_xor<1>(v)); v = fmaxf(v, swz_xor<2>(v)); v = fmaxf(v, swz_xor<4>(v)); v = fmaxf(v, swz_xor<8>(v)); { float a, b; rows16(v, a, b); v = fmaxf(a, b); }
    float lo, hi; halves(v, lo, hi); return fmaxf(lo, hi);
}
struct Args { const float* in[30]; float* out; unsigned char* ws; int ph_lo, ph_hi; };
typedef __attribute__((address_space(4))) const Args* KArgsPtr;
__device__ __forceinline__ KArgsPtr kargs() { KArgsPtr p = (KArgsPtr)__builtin_amdgcn_kernarg_segment_ptr(); asm volatile("" : "+s"(p)); return p; }
__device__ __forceinline__ int opq_s(int x) { asm volatile("" : "+s"(x)); return x; }
__device__ __forceinline__ const float* arg_in(int i) { return kargs()->in[i]; }
__device__ __forceinline__ float* arg_out() { return kargs()->out; }
__device__ __forceinline__ unsigned char* arg_ws() { return kargs()->ws; }

namespace pg8 {
constexpr int BM = 256, BK = 64, HALF = 128, HTB = HALF * BK * 2, STAGE_BYTES = 8 * HTB, NXCD = 8, WGM = 8;
__host__ __device__ __forceinline__ int lds_byte(int r, int c) { const int st = (r >> 4) * 2 + (c >> 5), rr = r & 15, cc = c & 31, ob = rr * 64 + cc * 2; return st * 1024 + (ob ^ (((ob >> 9) & 1) << 5)); }
__host__ __device__ __forceinline__ void stage_rc(int b, int& R, int& C) { const int st = b / 1024, sb = b % 1024, swz = sb ^ (((sb >> 9) & 1) << 5); R = (st >> 1) * 16 + swz / 64; C = (st & 1) * 32 + (swz % 64) / 2; }
__host__ __device__ __forceinline__ int perm32(int rho) { const int n = rho >> 4, i = rho & 15; return 8 * (i >> 2) + 4 * n + (i & 3); }

struct Unit { int pm, pn, e, mt, se; };

__device__ __forceinline__ bool static_unit_L(long L, int nM, int nN, int& pm, int& pn) {
    const int nwg = nM * nN; if (L >= nwg) return false;
    int wgid = (int)L; { const int q = nwg / NXCD, r = nwg % NXCD, xcd = wgid % NXCD, off = wgid / NXCD; wgid = (xcd < r ? xcd * (q + 1) : r * (q + 1) + (xcd - r) * q) + off; }
    const int nig = WGM * nN, gid = wgid / nig, fm = gid * WGM, gsz = (nM - fm) < WGM ? (nM - fm) : WGM;
    pm = fm + ((wgid % nig) % gsz); pn = (wgid % nig) / gsz; return true;
}
__device__ __forceinline__ bool static_unit(int i, int G, int c, int nM, int nN, int& pm, int& pn) { return static_unit_L((long)i * G + c, nM, nN, pm, pn); }
struct DenseOrder {
    static constexpr bool GATHER = false;
    const char* A; const char* B; int nM, nN, G, c; unsigned tstep;
    __device__ __forceinline__ void init(const void* A_, const void* B_, int M, int N, int K, int G_, int c_) { A = (const char*)A_; B = (const char*)B_; nM = M / BM; nN = N / BM; G = G_; c = c_; tstep = (unsigned)BM * K * 2; }
    __device__ __forceinline__ bool next(int i, Unit& u) const { u.e = 0; u.mt = 0; u.se = 0; return static_unit(i, G, c, nM, nN, u.pm, u.pn); }
    __device__ __forceinline__ unsigned aoff(const Unit& u) const { return (unsigned)u.pm * (unsigned)tstep; }
    __device__ __forceinline__ unsigned boff(const Unit& u) const { return (unsigned)u.pn * (unsigned)tstep; }
    __device__ __forceinline__ void rows(const Unit&, int, int, unsigned (&)[2][2]) const {}
};
template <int NSE> struct MoeOrder {
    static constexpr bool GATHER = false;
    const char* A; const char* B; const LAS int* tab; int se0, pm0, nM, nN, G, c; unsigned tstep, bstride;
    int hv = 0, skip = 0;
    __device__ __forceinline__ void init(const void* A_, const void* B_, const LAS int* tab_, int se0_, int nN_, unsigned tstep_, unsigned bstride_, int G_, int c_) {
        A = (const char*)A_; B = (const char*)B_; tab = tab_; se0 = se0_; pm0 = __builtin_amdgcn_readfirstlane(tab_[16 + se0_]); nM = __builtin_amdgcn_readfirstlane(tab_[16 + se0_ + NSE]) - pm0;
        nN = nN_; tstep = tstep_; bstride = bstride_; G = G_; c = c_; }
    __device__ __forceinline__ bool next(int i, Unit& u) const {
        const int Gl = G - hv; long L;
        if (c >= hv) L = i < skip ? (long)i * Gl + (c - hv) : (long)skip * Gl + (long)(i - skip) * G + c; else L = (long)skip * Gl + (long)i * G + c;
        int pl; if (!static_unit_L(L, nM, nN, pl, u.pn)) return false;
        const int pm = pm0 + pl; int se = se0;
#pragma unroll
        for (int j = 1; j < NSE; ++j) se += (pm >= tab[16 + se0 + j]) ? 1 : 0;
        se = __builtin_amdgcn_readfirstlane(se);
        u.pm = pm; u.se = se; u.e = se & 7; u.mt = __builtin_amdgcn_readfirstlane(pm - tab[16 + se]); return true;
    }
    __device__ __forceinline__ unsigned aoff(const Unit& u) const { return (unsigned)u.pm * (unsigned)tstep; }
    __device__ __forceinline__ unsigned boff(const Unit& u) const { return (unsigned)u.e * (unsigned)bstride + (unsigned)u.pn * (unsigned)tstep; }
    __device__ __forceinline__ void rows(const Unit&, int, int, unsigned (&)[2][2]) const {}
};

struct EpiBf16 {
    static constexpr bool PERM = true; static constexpr int NPRE = 8;
    bf16* O; int ldc; const float* rs; float wsc;
    __device__ __forceinline__ void preload(float (&pre)[8], const Unit& u, int wr, int fr) const {
#pragma unroll
        for (int i = 0; i < 8; ++i) pre[i] = rs[u.pm * BM + wr * 64 + fr + (i >> 2) * HALF + (i & 3) * 16];
    }
    __device__ __forceinline__ void operator()(const f32x4 (&acc)[2][2][4][2], const Unit& u, int wr, int wc, int fr, int fq, const float (&rsv)[8]) const {
        const int row0 = u.pm * BM + wr * 64 + fr, col0 = u.pn * BM + wc * 32 + 8 * fq;
#pragma unroll
        for (int ai = 0; ai < 2; ++ai)
#pragma unroll
            for (int m = 0; m < 4; ++m) { const int r = row0 + ai * HALF + m * 16; bf16* rowp = O + (size_t)r * ldc + col0; const float rs = rsv[ai * 4 + m] * wsc;
#pragma unroll
                for (int bj = 0; bj < 2; ++bj) { const f32x4 v0 = acc[ai][bj][m][0] * rs, v1 = acc[ai][bj][m][1] * rs;
                    u32x4 w; w.x = pk2(v0[0], v0[1]); w.y = pk2(v0[2], v0[3]); w.z = pk2(v1[0], v1[1]); w.w = pk2(v1[2], v1[3]);
                    *(u32x4*)(rowp + bj * HALF) = w; } }
    }
};
template <bool RF32, bool SCALED, bool SSOUT = false> struct EpiResB {
    static constexpr int NPRE = SCALED ? 8 : 0; static constexpr bool PERM = true;
    const float* R; bf16* XB; const float* ys; float wsc; float* SS;
    __device__ __forceinline__ void preload(float (&pre)[8], const Unit& u, int wr, int fr) const {
#pragma unroll
        for (int i = 0; i < 8; ++i) pre[i] = ys[u.pm * BM + wr * 64 + fr + (i >> 2) * HALF + (i & 3) * 16];
    }
    __device__ __forceinline__ void operator()(const f32x4 (&acc)[2][2][4][2], const Unit& u, int wr, int wc, int fr, int fq, const float (&pre)[8]) const { run(acc, u, wr, wc, fr, fq, pre); }
    __device__ __forceinline__ void operator()(const f32x4 (&acc)[2][2][4][2], const Unit& u, int wr, int wc, int fr, int fq) const { const float one[8] = {1.f, 1.f, 1.f, 1.f, 1.f, 1.f, 1.f, 1.f}; run(acc, u, wr, wc, fr, fq, one); }
    __device__ __forceinline__ void run(const f32x4 (&acc)[2][2][4][2], const Unit& u, int wr, int wc, int fr, int fq, const float (&pre)[8]) const {
        const int row0 = u.pm * BM + wr * 64 + fr, col0 = u.pn * BM + wc * 32 + 8 * fq;
#pragma unroll
        for (int aj = 0; aj < 4; ++aj) { const int ai = aj >> 1, m0 = 2 * (aj & 1); constexpr int MG = 2;
            f32x4 xr[4][2][2]; u32x4 xb_[4][2];
#pragma unroll
            for (int m = m0; m < m0 + MG; ++m) { const size_t ro = (size_t)(row0 + ai * HALF + m * 16) * D + col0;
#pragma unroll
                for (int bj = 0; bj < 2; ++bj) {
                    if constexpr (RF32) { xr[m][bj][0] = *(const f32x4*)(R + ro + bj * HALF); xr[m][bj][1] = *(const f32x4*)(R + ro + bj * HALF + 4); }
                    else xb_[m][bj] = *(const u32x4*)(XB + ro + bj * HALF); } }
            asm volatile("" ::: "memory");
#pragma unroll
            for (int m = m0; m < m0 + MG; ++m) { const int r = row0 + ai * HALF + m * 16; const size_t ro = (size_t)r * D + col0; const float f = SCALED ? pre[ai * 4 + m] * wsc : 1.f;
                f32x4 xv[2][2];
#pragma unroll
                for (int bj = 0; bj < 2; ++bj) {
                    if constexpr (RF32) { xv[bj][0] = xr[m][bj][0]; xv[bj][1] = xr[m][bj][1]; }
                    else { const u32x4 b = xb_[m][bj]; xv[bj][0] = (f32x4){bf_lo(b.x), bf_hi(b.x), bf_lo(b.y), bf_hi(b.y)}; xv[bj][1] = (f32x4){bf_lo(b.z), bf_hi(b.z), bf_lo(b.w), bf_hi(b.w)}; } }
                float sq = 0.f;
#pragma unroll
                for (int bj = 0; bj < 2; ++bj) { const f32x4 x0 = xv[bj][0] + acc[ai][bj][m][0] * f, x1 = xv[bj][1] + acc[ai][bj][m][1] * f;
                    if constexpr (SSOUT) sq += ((x0.x * x0.x + x0.y * x0.y) + (x0.z * x0.z + x0.w * x0.w)) + ((x1.x * x1.x + x1.y * x1.y) + (x1.z * x1.z + x1.w * x1.w));
                    u32x4 o; o.x = pk2(x0.x, x0.y); o.y = pk2(x0.z, x0.w); o.z = pk2(x1.x, x1.y); o.w = pk2(x1.z, x1.w); *(u32x4*)(XB + ro + bj * HALF) = o; }
                if constexpr (SSOUT) { sq = sum_rows16(sq); sq = sum_halves(sq); if (fq == 0) SS[(size_t)r * 16 + 4 * u.pn + wc] = sq; } }
        }
    }
};
__device__ __forceinline__ float silu_mul(float g, float u) { return g * __builtin_amdgcn_rcpf(1.0f + __builtin_amdgcn_exp2f(-g * LOG2E)) * u; }
struct EpiSwiGLU {
    static constexpr bool PERM = true; static constexpr int NPRE = 8;
    bf16* H; int ldh; const float* rs; float wsc;
    __device__ __forceinline__ void preload(float (&pre)[8], const Unit& u, int wr, int fr) const {
#pragma unroll
        for (int i = 0; i < 8; ++i) pre[i] = rs[u.pm * BM + wr * 64 + fr + (i >> 2) * HALF + (i & 3) * 16];
    }
    __device__ __forceinline__ void operator()(const f32x4 (&acc)[2][2][4][2], const Unit& u, int wr, int wc, int fr, int fq, const float (&rsv)[8]) const {
        const int row0 = u.pm * BM + wr * 64 + fr, col0 = u.pn * HALF + wc * 32 + 8 * fq;
#pragma unroll
        for (int ai = 0; ai < 2; ++ai)
#pragma unroll
            for (int m = 0; m < 4; ++m) { const int r = row0 + ai * HALF + m * 16; bf16* rowp = H + (size_t)r * ldh + col0; const float rs = rsv[ai * 4 + m] * wsc;
                const f32x4 g0 = acc[ai][0][m][0] * rs, g1 = acc[ai][0][m][1] * rs, u0 = acc[ai][1][m][0] * rs, u1 = acc[ai][1][m][1] * rs;
                u32x4 w; w.x = pk2(silu_mul(g0[0], u0[0]), silu_mul(g0[1], u0[1])); w.y = pk2(silu_mul(g0[2], u0[2]), silu_mul(g0[3], u0[3]));
                w.z = pk2(silu_mul(g1[0], u1[0]), silu_mul(g1[1], u1[1])); w.w = pk2(silu_mul(g1[2], u1[2]), silu_mul(g1[3], u1[3]));
                *(u32x4*)rowp = w; }
    }
};
struct EpiSwiGLUF8 {
    static constexpr bool PERM = true; static constexpr int NPRE = 8;
    unsigned char* H; int ldh; const float* rs; float wsc;
    __device__ __forceinline__ void preload(float (&pre)[8], const Unit& u, int wr, int fr) const {
#pragma unroll
        for (int i = 0; i < 8; ++i) pre[i] = rs[u.pm * BM + wr * 64 + fr + (i >> 2) * HALF + (i & 3) * 16];
    }
    __device__ __forceinline__ void operator()(const f32x4 (&acc)[2][2][4][2], const Unit& u, int wr, int wc, int fr, int fq, const float (&rsv)[8]) const {
        const int row0 = u.pm * BM + wr * 64 + fr, col0 = u.pn * HALF + wc * 32 + 8 * fq; const float sc = (float)(1 << SC_HID8);
#pragma unroll
        for (int ai = 0; ai < 2; ++ai)
#pragma unroll
            for (int m = 0; m < 4; ++m) { unsigned char* rowp = H + (size_t)(row0 + ai * HALF + m * 16) * ldh + col0; const float f = rsv[ai * 4 + m] * wsc;
                const f32x4 g0 = acc[ai][0][m][0] * f, g1 = acc[ai][0][m][1] * f, u0 = acc[ai][1][m][0] * f, u1 = acc[ai][1][m][1] * f;
                u32x2 w; w.x = pk4_fp8(sc * silu_mul(g0[0], u0[0]), sc * silu_mul(g0[1], u0[1]), sc * silu_mul(g0[2], u0[2]), sc * silu_mul(g0[3], u0[3]));
                w.y = pk4_fp8(sc * silu_mul(g1[0], u1[0]), sc * silu_mul(g1[1], u1[1]), sc * silu_mul(g1[2], u1[2]), sc * silu_mul(g1[3], u1[3]));
                *(u32x2*)rowp = w; }
    }
};
struct EpiSwiGLU8 {
    static constexpr bool PERM = false; static constexpr int NPRE = 0;
    unsigned char* H; int ldh;
    __device__ __forceinline__ void operator()(const f32x4 (&acc)[2][2][4][2], const Unit& u, int wr, int wc, int fr, int fq) const {
        const int row0 = u.pm * BM + wr * 64 + fr, col0 = u.pn * HALF + wc * 32 + 4 * fq; const float sc = (float)(1 << SC_HID8);
#pragma unroll
        for (int ai = 0; ai < 2; ++ai)
#pragma unroll
            for (int m = 0; m < 4; ++m) { unsigned char* rowp = H + (size_t)(row0 + ai * HALF + m * 16) * ldh + col0;
#pragma unroll
                for (int n = 0; n < 2; ++n) { const f32x4 g = acc[ai][0][m][n], up = acc[ai][1][m][n];
                    *(unsigned*)(rowp + 16 * n) = pk4_fp8(sc * silu_mul(g[0], up[0]), sc * silu_mul(g[1], up[1]), sc * silu_mul(g[2], up[2]), sc * silu_mul(g[3], up[3])); } }
    }
};
struct EpiMoeDown {
    static constexpr bool PERM = false; static constexpr int NPRE = 0;
    const LAS int* tab; int first;
    __device__ __forceinline__ void operator()(const f32x4 (&acc)[2][2][4][2], const Unit& u, int wr, int wc, int fr, int fq) const {
        float* C = arg_out(); const int cnt = tab[u.se]; const int* lt = (const int*)(arg_ws() + WS_LTOK) + (size_t)u.se * NTOK; const float* lg = (const float*)(arg_ws() + WS_LGATE) + (size_t)u.se * NTOK;
        const int p0 = u.mt * 256 + wr * 64 + fr, col0 = u.pn * BM + wc * 32 + 4 * fq;
#pragma unroll
        for (int ai = 0; ai < 2; ++ai)
#pragma unroll
            for (int m = 0; m < 4; ++m) { const int p = p0 + ai * HALF + m * 16;
                if (p < cnt) { const int tok = lt[p]; const float g = lg[p]; float* rowp = C + (size_t)tok * D + col0; bf16* xrow = (bf16*)(arg_ws() + WS_XB) + (size_t)tok * D + col0;
                    f32x4 rv[2][2];
#pragma unroll
                    for (int bj = 0; bj < 2; ++bj)
#pragma unroll
                        for (int n = 0; n < 2; ++n) { const u32x2 b = *(const u32x2*)(xrow + bj * HALF + n * 16); rv[bj][n] = (f32x4){bf_lo(b.x), bf_hi(b.x), bf_lo(b.y), bf_hi(b.y)}; }
#pragma unroll
                    for (int bj = 0; bj < 2; ++bj)
#pragma unroll
                        for (int n = 0; n < 2; ++n) { const f32x4 x = rv[bj][n] + g * acc[ai][bj][m][n];
                            if (first) { u32x2 o; o.x = pk2(x.x, x.y); o.y = pk2(x.z, x.w); *(u32x2*)(xrow + bj * HALF + n * 16) = o; }
                            else *(f32x4*)(rowp + bj * HALF + n * 16) = x; } } }
    }
};

typedef int v8i_t __attribute__((ext_vector_type(8)));
typedef int v4i_t __attribute__((ext_vector_type(4)));
__device__ __forceinline__ v8i_t cat8(bf16x8 a, bf16x8 b) { return __builtin_shufflevector(__builtin_bit_cast(v4i_t, a), __builtin_bit_cast(v4i_t, b), 0, 1, 2, 3, 4, 5, 6, 7); }
template <class Epi, class Sched, int SA = -1, int SB = -1, bool I8 = false>
__device__ __forceinline__ void gemm_phase(LAS unsigned char* lds, const int K, const Sched& S, const Epi& E, const int wv) {
    int wid_ = wv; asm volatile("" : "+s"(wid_));
    int tid_ = wid_ * 64 + lane_id(); asm volatile("" : "+v"(tid_));
    const int tid = tid_, wid = wid_, lane = tid & 63, wr = wid >> 2, wc = wid & 3, fr = lane & 15, fq = lane >> 4;
    const int nt = K / BK;
    unsigned voffB[2];
    unsigned offAc[2][2];
    LAS u32x4* stash = (LAS u32x4*)(lds + STAGE_BYTES) + tid;
    const unsigned kstep = (unsigned)(BK * 2);
    const unsigned hstep = (unsigned)HALF * (unsigned)K * 2u;
#pragma unroll
    for (int i = 0; i < 2; ++i) { int R, C; stage_rc(tid * 16 + i * 8192, R, C); const int Rb = Epi::PERM ? ((R & ~31) + perm32(R & 31)) : R;
        voffB[i] = (unsigned)(Rb * K + C) * 2u;
        offAc[0][i] = (unsigned)(R * K + C) * 2u; offAc[1][i] = offAc[0][i] + hstep; }
    const __amdgpu_buffer_rsrc_t rA = __builtin_amdgcn_make_buffer_rsrc((void*)S.A, 0, 0x7ffffff0, 0x00020000);
    const __amdgpu_buffer_rsrc_t rB = __builtin_amdgcn_make_buffer_rsrc((void*)S.B, 0, 0x7ffffff0, 0x00020000);
    const unsigned ldsw = (unsigned)wid * 1024u;
    const int aoff = lds_byte(wr * 64 + fr, fq * 8), boff = lds_byte(wc * 32 + fr, fq * 8);
#define PG8_SA(b, h) (((b) * 2 + (h)) * HTB)
#define PG8_SB(b, h) ((4 + (b) * 2 + (h)) * HTB)
#define PG8_STAGE_R(bufoff, rs, soff, voff) do { _Pragma("unroll") for (int _i = 0; _i < 2; ++_i) \
        __builtin_amdgcn_raw_ptr_buffer_load_lds(rs, (LAS unsigned*)(lds + (bufoff) + ldsw + _i * 8192), 16, (voff)[_i], (soff), 0, 0); } while (0)
#define PG8_STAGE_A(bufoff, soff, voff) PG8_STAGE_R(bufoff, rA, soff, voff)
#define PG8_STAGE_A1(bufoff, soff) do { if constexpr (Sched::GATHER) PG8_STAGE_R(bufoff, rA, soff, offAc[1]); else PG8_STAGE_R(bufoff, rA, (soff) + hstep, offAc[0]); } while (0)
#define PG8_STAGE_B(bufoff, soff, voff) PG8_STAGE_R(bufoff, rB, soff, voff)
#define PG8_LDA(dst, b, h) do { _Pragma("unroll") for (int m = 0; m < 4; ++m) _Pragma("unroll") for (int k = 0; k < 2; ++k) dst[m][k] = *(const LAS bf16x8*)(lds + PG8_SA(b, h) + aoff + m * 2048 + k * 1024); } while (0)
#define PG8_LDB(dst, b, h) do { _Pragma("unroll") for (int n = 0; n < 2; ++n) _Pragma("unroll") for (int k = 0; k < 2; ++k) dst[n][k] = *(const LAS bf16x8*)(lds + PG8_SB(b, h) + boff + n * 2048 + k * 1024); } while (0)
#define PG8_MMA(ai, bj, At, Bt) do { __builtin_amdgcn_s_setprio(1); _Pragma("unroll") for (int m = 0; m < 4; ++m) _Pragma("unroll") for (int n = 0; n < 2; ++n) { \
        if constexpr (SA >= 0) acc[ai][bj][m][n] = __builtin_amdgcn_mfma_scale_f32_16x16x128_f8f6f4(cat8(Bt[n][0], Bt[n][1]), cat8(At[m][0], At[m][1]), acc[ai][bj][m][n], 0, 0, 0, scl_b, 0, scl_a); \
        else if constexpr (I8) { _Pragma("unroll") for (int k = 0; k < 2; ++k) acc[ai][bj][m][n] = __builtin_bit_cast(f32x4, __builtin_amdgcn_mfma_i32_16x16x64_i8(__builtin_bit_cast(v4i_t, Bt[n][k]), __builtin_bit_cast(v4i_t, At[m][k]), __builtin_bit_cast(v4i_t, acc[ai][bj][m][n]), 0, 0, 0)); } \
        else { _Pragma("unroll") for (int k = 0; k < 2; ++k) acc[ai][bj][m][n] = __builtin_amdgcn_mfma_f32_16x16x32_bf16(Bt[n][k], At[m][k], acc[ai][bj][m][n], 0, 0, 0); } } \
        __builtin_amdgcn_s_setprio(0); } while (0)
#define PG8_WAIT_V(n) asm volatile("s_waitcnt vmcnt(" #n ")" ::: "memory")
#define PG8_WAIT_L(n) asm volatile("s_waitcnt lgkmcnt(" #n ")" ::: "memory")
#define PG8_BAR __builtin_amdgcn_s_barrier()
#define PG8_SCHED __builtin_amdgcn_sched_barrier(0)
    int scl_a = SA * 0x01010101; asm volatile("" : "+v"(scl_a));
    const int scl_b = (SA == SB) ? scl_a : SB * 0x01010101;
    Unit cur, nxt; int ui = 0;
    if (!S.next(0, cur)) return;
    f32x4 acc[2][2][4][2];
#pragma unroll
    for (int a = 0; a < 2; ++a)
#pragma unroll
        for (int b = 0; b < 2; ++b)
#pragma unroll
            for (int m = 0; m < 4; ++m)
#pragma unroll
                for (int n = 0; n < 2; ++n) acc[a][b][m][n] = (f32x4){0.f, 0.f, 0.f, 0.f};
    bf16x8 At[4][2], B0[2][2], B1[2][2];
    unsigned cA = S.aoff(cur), cB = S.boff(cur);
    if constexpr (Sched::GATHER) S.rows(cur, tid, K, offAc);
    PG8_STAGE_B(PG8_SB(0, 0), cB, voffB); PG8_STAGE_B(PG8_SB(0, 1), cB + hstep, voffB); PG8_STAGE_A(PG8_SA(0, 0), cA, offAc[0]); PG8_STAGE_A1(PG8_SA(0, 1), cA);
    if (wr == 1) PG8_BAR;
    PG8_WAIT_V(2); PG8_BAR;
    PG8_STAGE_B(PG8_SB(1, 0), cB + kstep, voffB); PG8_STAGE_A(PG8_SA(1, 0), cA + kstep, offAc[0]); PG8_STAGE_B(PG8_SB(1, 1), cB + hstep + kstep, voffB);
    PG8_WAIT_V(6); PG8_BAR;
    for (;;) {
        const bool has_next = S.next(ui + 1, nxt);
        const unsigned nA = has_next ? S.aoff(nxt) : cA, nB = has_next ? S.boff(nxt) : cB;
        float epre[Epi::NPRE ? Epi::NPRE : 1];
        if constexpr (Epi::NPRE > 0) { int l1 = lane_id(); asm volatile("" : "+v"(l1)); E.preload(epre, cur, wr, l1 & 15); }
        if constexpr (Sched::GATHER) { unsigned offAn[2][2];
            if (has_next) S.rows(nxt, tid, K, offAn);
            else {
#pragma unroll
                for (int h = 0; h < 2; ++h) { offAn[h][0] = offAc[h][0]; offAn[h][1] = offAc[h][1]; } }
            *stash = (u32x4){offAn[0][0], offAn[0][1], offAn[1][0], offAn[1][1]}; }
#pragma clang loop unroll(disable)
        for (int t = 0; t < nt; t += 2) {
            const bool last = (t == nt - 2);
            const unsigned a1 = cA + (unsigned)(t + 1) * kstep;
            const unsigned a2 = last ? nA : cA + (unsigned)(t + 2) * kstep, b2 = last ? nB : cB + (unsigned)(t + 2) * kstep;
            const unsigned a3 = a2 + kstep, b3 = b2 + kstep;
            PG8_LDB(B0, 0, 0); PG8_LDB(B1, 0, 1); PG8_SCHED; PG8_LDA(At, 0, 0); PG8_STAGE_A1(PG8_SA(1, 1), a1);
            if constexpr (Sched::GATHER) {
                const unsigned lm = last ? 0xffffffffu : 0u; const u32x4 nx = *stash;
                offAc[0][0] = (offAc[0][0] & ~lm) | (nx.x & lm); offAc[0][1] = (offAc[0][1] & ~lm) | (nx.y & lm); offAc[1][0] = (offAc[1][0] & ~lm) | (nx.z & lm); offAc[1][1] = (offAc[1][1] & ~lm) | (nx.w & lm); }
            PG8_WAIT_V(8); PG8_WAIT_L(0); PG8_BAR; PG8_MMA(0, 0, At, B0); PG8_MMA(0, 1, At, B1); PG8_BAR; PG8_SCHED;
            PG8_LDA(At, 0, 1); PG8_STAGE_B(PG8_SB(0, 0), b2, voffB); PG8_STAGE_B(PG8_SB(0, 1), b2 + hstep, voffB); PG8_STAGE_A(PG8_SA(0, 0), a2, offAc[0]);
            PG8_WAIT_V(8); PG8_WAIT_L(0); PG8_BAR; PG8_MMA(1, 0, At, B0); PG8_MMA(1, 1, At, B1); PG8_BAR; PG8_SCHED;
            PG8_LDB(B0, 1, 0); PG8_LDB(B1, 1, 1); PG8_SCHED; PG8_LDA(At, 1, 0); PG8_STAGE_A1(PG8_SA(0, 1), a2);
            PG8_WAIT_V(8); PG8_WAIT_L(0); PG8_BAR; PG8_MMA(0, 0, At, B0); PG8_MMA(0, 1, At, B1); PG8_BAR; PG8_SCHED;
            PG8_LDA(At, 1, 1); PG8_STAGE_B(PG8_SB(1, 0), b3, voffB); PG8_STAGE_B(PG8_SB(1, 1), b3 + hstep, voffB); PG8_STAGE_A(PG8_SA(1, 0), a3, offAc[0]);
            PG8_WAIT_V(8); PG8_WAIT_L(0); PG8_BAR; PG8_MMA(1, 0, At, B0); PG8_MMA(1, 1, At, B1); PG8_BAR; PG8_SCHED;
        }
        if (wr == 0) PG8_BAR;
        PG8_SCHED;
        if constexpr (I8) {
#pragma unroll
            for (int a = 0; a < 2; ++a)
#pragma unroll
                for (int b = 0; b < 2; ++b)
#pragma unroll
                    for (int m = 0; m < 4; ++m)
#pragma unroll
                        for (int n = 0; n < 2; ++n) { const v4i_t q = __builtin_bit_cast(v4i_t, acc[a][b][m][n]); acc[a][b][m][n] = (f32x4){(float)q.x, (float)q.y, (float)q.z, (float)q.w}; } }
        { int l2 = lane_id(); asm volatile("" : "+v"(l2)); if constexpr (Epi::NPRE > 0) E(acc, cur, wr, wc, l2 & 15, l2 >> 4, epre); else E(acc, cur, wr, wc, l2 & 15, l2 >> 4); }
        PG8_SCHED;
        if (!has_next) break;
#pragma unroll
        for (int a = 0; a < 2; ++a)
#pragma unroll
            for (int b = 0; b < 2; ++b)
#pragma unroll
                for (int m = 0; m < 4; ++m)
#pragma unroll
                    for (int n = 0; n < 2; ++n) acc[a][b][m][n] = (f32x4){0.f, 0.f, 0.f, 0.f};
        PG8_SCHED;
        cur = nxt; cA = nA; cB = nB; ++ui;
        if (wr == 1) PG8_BAR;
    }
    PG8_WAIT_V(0);
    PG8_BAR;
#undef PG8_SA
#undef PG8_SB
#undef PG8_STAGE_R
#undef PG8_STAGE_A
#undef PG8_STAGE_A1
#undef PG8_STAGE_B
#undef PG8_LDA
#undef PG8_LDB
#undef PG8_MMA
#undef PG8_WAIT_V
#undef PG8_WAIT_L
#undef PG8_BAR
#undef PG8_SCHED
}
}

#define XB_TMO      128
#define XB_XCNT(j)  (256  + 64 * (j))
#define XB_XSUB(j)  (1280 + 64 * (j))
#define XB_XGEN(j)  (2304 + 64 * (j))
#define XB_TOP      3328
#define XB_TOPGEN   3392
#define XCD_BAR_WORDS 3456
#define XB_SPIN_CAP (1u << 18)
__device__ __forceinline__ unsigned long long xb_z() { unsigned long long z; asm volatile("v_mov_b64 %0, 0" : "=v"(z)); return z; }
__device__ __forceinline__ unsigned xb_ld(unsigned* p)              { return __hip_atomic_load(p + xb_z(), __ATOMIC_RELAXED, __HIP_MEMORY_SCOPE_AGENT); }
__device__ __forceinline__ unsigned xb_add(unsigned* p, unsigned v) { return __hip_atomic_fetch_add(p + xb_z(), v, __ATOMIC_RELAXED, __HIP_MEMORY_SCOPE_AGENT); }
__device__ __forceinline__ unsigned xb_xcc_id() { return (unsigned)__builtin_amdgcn_s_getreg((3 << 11) | 20) & 0xFu; }
#define XB_SPIN(cond, bar) do { unsigned _sp = 0; while (cond) { __builtin_amdgcn_s_sleep(1); \
    if ((++_sp & 255u) == 0u) { if (xb_ld(&(bar)[XB_TMO])) break; if (_sp > XB_SPIN_CAP) { (void)xb_add(&(bar)[XB_TMO], 1u); break; } } } } while (0)
struct XcdBarrier { unsigned* bar; unsigned x; volatile LAS unsigned* st; };
__device__ __forceinline__ XcdBarrier xcd_barrier_post(unsigned* bar, volatile LAS unsigned* st, bool t0) {
    XcdBarrier b; b.bar = bar; b.x = xb_xcc_id(); b.st = st;
    if (t0) (void)xb_add(&bar[XB_XCNT(b.x)], 1u);
    return b;
}
__device__ __forceinline__ void xcd_barrier_complete(unsigned* bar, unsigned x, unsigned& nloc, unsigned& nx) {
    const unsigned G = gridDim.x * gridDim.y * gridDim.z;
    unsigned sum, cnt, mine, sp = 0u;
    for (;;) {
        sum = 0u; cnt = 0u; mine = 0u;
#pragma unroll
        for (unsigned j = 0; j < 16; ++j) { const unsigned c = xb_ld(&bar[XB_XCNT(j)]); sum += c; cnt += (c > 0u) ? 1u : 0u; mine = (j == x) ? c : mine; }
        if (sum == G) break;
        __builtin_amdgcn_s_sleep(1);
        if ((++sp & 255u) == 0u) { if (xb_ld(&bar[XB_TMO])) break; if (sp > XB_SPIN_CAP) { (void)xb_add(&bar[XB_TMO], 1u); break; } }
    }
    nloc = mine > 0u ? mine : 1u; nx = cnt > 0u ? cnt : 1u;
}
__device__ __forceinline__ void xcd_barrier(const XcdBarrier& b, bool t0) {
    asm volatile("s_waitcnt vmcnt(0)" ::: "memory");
    __syncthreads();
    if (t0) {
        unsigned* bar = b.bar;
        __builtin_amdgcn_s_waitcnt(0);
        unsigned nloc = b.st[0], nx = b.st[1];
        if (nloc == 0u) { xcd_barrier_complete(bar, b.x, nloc, nx); b.st[0] = nloc; b.st[1] = nx; }
        const unsigned old = xb_add(&bar[XB_XSUB(b.x)], 1u);
        const unsigned gen = old / nloc;
        if (old + 1u == (gen + 1u) * nloc) {
            __builtin_amdgcn_fence(__ATOMIC_RELEASE, "agent");
            asm volatile("s_waitcnt vmcnt(0)" ::: "memory");
            const unsigned og = xb_add(&bar[XB_TOP], 1u);
            const unsigned tg = og / nx;
            if (og + 1u == (tg + 1u) * nx) xb_add(&bar[XB_TOPGEN], 1u);
            else XB_SPIN(xb_ld(&bar[XB_TOPGEN]) == tg, bar);
            __builtin_amdgcn_fence(__ATOMIC_ACQUIRE, "agent");
            xb_add(&bar[XB_XGEN(b.x)], 1u);
            asm volatile("s_waitcnt vmcnt(0)" ::: "memory");
        } else {
            XB_SPIN(xb_ld(&bar[XB_XGEN(b.x)]) == gen, bar);
            __builtin_amdgcn_fence(__ATOMIC_ACQUIRE, "agent");
            asm volatile("s_waitcnt vmcnt(0)" ::: "memory");
        }
    }
    __syncthreads();
}

__device__ __forceinline__ void transpose_item(const float* W, int N, int K, bf16* WT, int k0, int n0, int drow0, const float* gk, LAS float* scr, int lane) {
    { const int kr = lane >> 3, q4 = 4 * (lane & 7); f32x4 v[8]; float g[8];
#pragma unroll
      for (int i = 0; i < 8; ++i) { v[i] = *(const f32x4*)(W + (size_t)(k0 + 8 * i + kr) * N + n0 + q4); g[i] = gk ? gk[k0 + 8 * i + kr] : 1.f; }
#pragma unroll
      for (int i = 0; i < 8; ++i) { LAS float* d = scr + (8 * i + kr) * 33 + q4; d[0] = v[i].x * g[i]; d[1] = v[i].y * g[i]; d[2] = v[i].z * g[i]; d[3] = v[i].w * g[i]; } }
    LDS_WAIT(); asm volatile("" ::: "memory");
    const int c = lane & 7;
#pragma unroll
    for (int j = 0; j < 4; ++j) { const int n = (lane >> 3) + 8 * j; const LAS float* s = scr + (8 * c) * 33 + n;
        u32x4 o; o.x = pk2(s[0 * 33], s[1 * 33]); o.y = pk2(s[2 * 33], s[3 * 33]); o.z = pk2(s[4 * 33], s[5 * 33]); o.w = pk2(s[6 * 33], s[7 * 33]);
        *(u32x4*)(WT + (size_t)(drow0 + n) * K + k0 + 8 * c) = o; }
    LDS_WAIT(); asm volatile("" ::: "memory");
}
__device__ __forceinline__ void transpose_item8(const float* W, int N, int K, unsigned char* WT, int k0, int n0, int drow0, float sc, LAS float* scr, int lane) {
    { const int kr = lane >> 3, q4 = 4 * (lane & 7); f32x4 v[16];
#pragma unroll
      for (int i = 0; i < 16; ++i) v[i] = *(const f32x4*)(W + (size_t)(k0 + 8 * i + kr) * N + n0 + q4);
#pragma unroll
      for (int i = 0; i < 16; ++i) { LAS float* d = scr + (8 * i + kr) * 33 + q4; d[0] = v[i].x; d[1] = v[i].y; d[2] = v[i].z; d[3] = v[i].w; } }
    LDS_WAIT(); asm volatile("" ::: "memory");
    const int c = lane & 7;
#pragma unroll
    for (int j = 0; j < 4; ++j) { const int n = (lane >> 3) + 8 * j; const LAS float* s = scr + (16 * c) * 33 + n;
        u32x4 o; o.x = pk4_fp8(sc * s[0 * 33], sc * s[1 * 33], sc * s[2 * 33], sc * s[3 * 33]); o.y = pk4_fp8(sc * s[4 * 33], sc * s[5 * 33], sc * s[6 * 33], sc * s[7 * 33]);
        o.z = pk4_fp8(sc * s[8 * 33], sc * s[9 * 33], sc * s[10 * 33], sc * s[11 * 33]); o.w = pk4_fp8(sc * s[12 * 33], sc * s[13 * 33], sc * s[14 * 33], sc * s[15 * 33]);
        *(u32x4*)(WT + (size_t)(drow0 + n) * K + k0 + 16 * c) = o; }
    LDS_WAIT(); asm volatile("" ::: "memory");
}
__device__ __forceinline__ int conv_mat8(const float* W, int K, int N, unsigned char* WT, int nb, size_t sstride, size_t dstride, int mode, float sc, LAS float* scr, int gw, int NGW, int rot, int lane) {
    const int nblk = N / 32, per = (K / 128) * nblk, total = per * nb;
    int start = gw - rot; if (start < 0) start += NGW;
    for (int it = start; it < total; it += NGW) {
        const int bi = it / per, r = it - bi * per, kb = r / nblk, nbk = r - kb * nblk, n0 = 32 * nbk;
        const int drow0 = mode == 0 ? n0 : ((n0 >> 7) * 256 + (n0 & 127) + (mode == 2 ? 128 : 0));
        transpose_item8(W + (size_t)bi * sstride, N, K, WT + (size_t)bi * dstride, 128 * kb, n0, drow0, sc, scr, lane);
    }
    return (rot + total) % NGW;
}
__device__ __forceinline__ void transpose_item_i8(const float* W, int N, int K, unsigned char* WT, int k0, int n0, int drow0, float sc, const float* gk, LAS float* scr, int lane) {
    { const int kr = lane >> 3, q4 = 4 * (lane & 7); f32x4 v[16]; float g[16];
#pragma unroll
      for (int i = 0; i < 16; ++i) { v[i] = *(const f32x4*)(W + (size_t)(k0 + 8 * i + kr) * N + n0 + q4); g[i] = gk ? gk[k0 + 8 * i + kr] * sc : sc; }
#pragma unroll
      for (int i = 0; i < 16; ++i) { LAS float* d = scr + (8 * i + kr) * 33 + q4; d[0] = v[i].x * g[i]; d[1] = v[i].y * g[i]; d[2] = v[i].z * g[i]; d[3] = v[i].w * g[i]; } }
    LDS_WAIT(); asm volatile("" ::: "memory");
    const int c = lane & 7;
#pragma unroll
    for (int j = 0; j < 4; ++j) { const int n = (lane >> 3) + 8 * j; const LAS float* s = scr + (16 * c) * 33 + n;
        u32x4 o; o.x = pk4_i8(s[0 * 33], s[1 * 33], s[2 * 33], s[3 * 33]); o.y = pk4_i8(s[4 * 33], s[5 * 33], s[6 * 33], s[7 * 33]);
        o.z = pk4_i8(s[8 * 33], s[9 * 33], s[10 * 33], s[11 * 33]); o.w = pk4_i8(s[12 * 33], s[13 * 33], s[14 * 33], s[15 * 33]);
        *(u32x4*)(WT + (size_t)(drow0 + n) * K + k0 + 16 * c) = o; }
    LDS_WAIT(); asm volatile("" ::: "memory");
}
__device__ __forceinline__ int conv_mat_i8(const float* W, int K, int N, unsigned char* WT, int mode, float sc, const float* gk, LAS float* scr, int gw, int NGW, int rot, int lane) {
    const int nblk = N / 32, total = (K / 128) * nblk;
    int start = gw - rot; if (start < 0) start += NGW;
    for (int it = start; it < total; it += NGW) {
        const int kb = it / nblk, nbk = it - kb * nblk, n0 = 32 * nbk;
        const int drow0 = mode == 0 ? n0 : ((n0 >> 7) * 256 + (n0 & 127) + (mode == 2 ? 128 : 0));
        transpose_item_i8(W, N, K, WT, 128 * kb, n0, drow0, sc, gk, scr, lane);
    }
    return (rot + total) % NGW;
}
__device__ __forceinline__ void absmax_mat(const float* W, int K, int N, const float* gk, unsigned* dst, int gt, int NGT, int lane) {
    float mx = 0.f; const int n4 = N / 4, tot = K * n4;
    for (int i0 = gt; i0 < tot; i0 += 8 * NGT) {
        f32x4 v[8]; float g[8];
#pragma unroll
        for (int u = 0; u < 8; ++u) { const int i = i0 + u * NGT; const bool ok = i < tot; v[u] = ok ? ((const f32x4*)W)[i] : (f32x4){0.f, 0.f, 0.f, 0.f}; g[u] = (ok && gk) ? fabsf(gk[i / n4]) : 1.f; }
#pragma unroll
        for (int u = 0; u < 8; ++u) mx = fmaxf(mx, fmaxf(fmaxf(fabsf(v[u].x), fabsf(v[u].y)), fmaxf(fabsf(v[u].z), fabsf(v[u].w))) * g[u]);
    }
    mx = wave_max(mx);
    if (lane == 0) __hip_atomic_fetch_max(dst, __float_as_uint(mx), __ATOMIC_RELAXED, __HIP_MEMORY_SCOPE_AGENT);
}
__device__ __forceinline__ int conv_mat(const float* W, int K, int N, bf16* WT, int nb, size_t sstride, size_t dstride, int mode, const float* gk, LAS float* scr, int gw, int NGW, int rot, int lane) {
    const int nblk = N / 32, per = (K / 64) * nblk, total = per * nb;
    int start = gw - rot; if (start < 0) start += NGW;
    for (int it = start; it < total; it += NGW) {
        const int bi = it / per, r = it - bi * per, kb = r / nblk, nbk = r - kb * nblk, n0 = 32 * nbk;
        const int drow0 = mode == 0 ? n0 : ((n0 >> 7) * 256 + (n0 & 127) + (mode == 2 ? 128 : 0));
        transpose_item(W + (size_t)bi * sstride, N, K, WT + (size_t)bi * dstride, 64 * kb, n0, drow0, gk ? gk + (size_t)bi * K : nullptr, scr, lane);
    }
    return (rot + total) % NGW;
}
__device__ __forceinline__ void p0_prologue(LAS unsigned char* lds, int vcu, int G, int wv) {
    OPAQUE_TID(); OPAQUE_U(vcu); OPAQUE_U(G);
    LAS float* scr = (LAS float*)(lds + wave * 17408);
    const int gw = vcu * NWAVES + wave, NGW = G * NWAVES;
    unsigned char* ws = arg_ws();
    int rot = 0;
    { const int gt0 = vcu * (NWAVES * 64) + tid, NGT0 = G * NWAVES * 64; unsigned* wm = (unsigned*)(ws + WS_CTL) + CW_WMAX;
      if (I8_INPROJ) { absmax_mat(arg_in(2), D, INC, arg_in(1), wm + 0, gt0, NGT0, lane); absmax_mat(arg_in(2) + (size_t)D * INC, D, INC, arg_in(1) + D, wm + 64, gt0, NGT0, lane); }
      if (I8_FFN1) { absmax_mat(arg_in(23), D, DFF, arg_in(22), wm + 128, gt0, NGT0, lane); absmax_mat(arg_in(24), D, DFF, arg_in(22), wm + 128, gt0, NGT0, lane); }
      if (I8_OUTPROJ) { absmax_mat(arg_in(21), D, D, nullptr, wm + 192, gt0, NGT0, lane); absmax_mat(arg_in(21) + (size_t)D * D, D, D, nullptr, wm + 256, gt0, NGT0, lane); } }
    if (F8_FFN2) rot = conv_mat8(arg_in(25), DFF, D, ws + WS_WD, 1, 0, 0, 0, (float)(1 << SC_WD8), scr, gw, NGW, rot, lane);
    else rot = conv_mat(arg_in(25), DFF, D, (bf16*)(ws + WS_WD), 1, 0, 0, 0, nullptr, scr, gw, NGW, rot, lane);
    if (!I8_INPROJ) rot = conv_mat(arg_in(2), D, INC, (bf16*)(ws + WS_WIN), 2, (size_t)D * INC, (size_t)INC * D, 0, arg_in(1), scr, gw, NGW, rot, lane);
    if (!I8_OUTPROJ) rot = conv_mat(arg_in(21), D, D, (bf16*)(ws + WS_WOUT), 2, (size_t)D * D, (size_t)D * D, 0, nullptr, scr, gw, NGW, rot, lane);
    if (!I8_FFN1) { rot = conv_mat(arg_in(23), D, DFF, (bf16*)(ws + WS_WGU), 1, 0, 0, 1, arg_in(22), scr, gw, NGW, rot, lane); rot = conv_mat(arg_in(24), D, DFF, (bf16*)(ws + WS_WGU), 1, 0, 0, 2, arg_in(22), scr, gw, NGW, rot, lane); }
    rot = conv_mat8(arg_in(27), D, DFE, ws + WS_MGU8, NE, (size_t)D * DFE, (size_t)2 * DFE * D, 1, (float)(1 << SC_WGU8), scr, gw, NGW, rot, lane);
    rot = conv_mat8(arg_in(28), D, DFE, ws + WS_MGU8, NE, (size_t)D * DFE, (size_t)2 * DFE * D, 2, (float)(1 << SC_WGU8), scr, gw, NGW, rot, lane);
    rot = conv_mat8(arg_in(29), DFE, D, ws + WS_MD8, NE, (size_t)DFE * D, (size_t)D * DFE, 0, (float)(1 << SC_WD8), scr, gw, NGW, rot, lane);
    const int gt = vcu * (NWAVES * 64) + tid, NGT = G * NWAVES * 64;
    { bf16* wm = (bf16*)(ws + WS_GWM); const float* src = arg_in(11);
      for (int i = gt; i < 2 * 4 * 128 * 128; i += NGT) { const int s = i & 127, t = (i >> 7) & 127; wm[i] = (bf16)(pk2(s <= t ? src[i] : 0.f, 0.f) & 0xffffu); } }
    { bf16* wat = (bf16*)(ws + WS_WAT); bf16* wxt = (bf16*)(ws + WS_WXT); const float* sa = arg_in(15); const float* sx = arg_in(17);
      for (int i = gt; i < 2 * 4 * 64 * 64; i += NGT) { const int ii = i & 63, j = (i >> 6) & 63, lh = i >> 12; const int si = (lh << 12) + ii * 64 + j;
          wat[i] = (bf16)(pk2(sa[si], 0.f) & 0xffffu); wxt[i] = (bf16)(pk2(sx[si], 0.f) & 0xffffu); } }
    { unsigned* xn8 = (unsigned*)(ws + WS_XN8 + (size_t)NTOK * D); for (int i = gt; i < D / 4; i += NGT) xn8[i] = 0u; }
    { const float* x0 = arg_in(0); bf16* xb = (bf16*)(ws + WS_XB); float* rd = (float*)(ws + WS_RD);
      for (int m0 = 4 * gw; m0 < NTOK; m0 += 4 * NGW) { f32x4 v[4][4];
#pragma unroll
          for (int r = 0; r < 4; ++r)
#pragma unroll
              for (int j = 0; j < 4; ++j) v[r][j] = ((const f32x4*)(x0 + (size_t)(m0 + r) * D) + lane)[64 * j];
#pragma unroll
          for (int r = 0; r < 4; ++r) { unsigned long long* o8 = (unsigned long long*)(xb + (size_t)(m0 + r) * D) + lane; float sq = 0.f;
#pragma unroll
              for (int j = 0; j < 4; ++j) { sq += (v[r][j].x * v[r][j].x + v[r][j].y * v[r][j].y) + (v[r][j].z * v[r][j].z + v[r][j].w * v[r][j].w);
                  o8[64 * j] = (unsigned long long)pk2(v[r][j].x, v[r][j].y) | ((unsigned long long)pk2(v[r][j].z, v[r][j].w) << 32); }
              sq = wave_sum(sq); if (lane == 0) rd[m0 + r] = __builtin_amdgcn_rsqf(sq * (1.f / D) + EPS); } } }
}
__device__ __forceinline__ void p1_weights_i8(LAS unsigned char* lds, int vcu, int G, int wv, bool proj, bool ffn) {
    OPAQUE_TID();
    LAS float* scr = (LAS float*)(lds + wave * 17408);
    const int gw = vcu * NWAVES + wave, NGW = G * NWAVES;
    unsigned char* ws = arg_ws(); const unsigned* wm = (const unsigned*)(ws + WS_CTL) + CW_WMAX;
    float sc[5];
#pragma unroll
    for (int t = 0; t < 5; ++t) { const float a = __uint_as_float(__hip_atomic_load(wm + 64 * t, RLX_AGENT)); sc[t] = a > 0.f ? 127.f / a : 0.f; }
    int rot = 0;
    if (I8_INPROJ && proj) { rot = conv_mat_i8(arg_in(2), D, INC, ws + WS_WIN, 0, sc[0], arg_in(1), scr, gw, NGW, rot, lane);
        rot = conv_mat_i8(arg_in(2) + (size_t)D * INC, D, INC, ws + WS_WIN + (size_t)INC * D, 0, sc[1], arg_in(1) + D, scr, gw, NGW, rot, lane); }
    if (I8_FFN1 && ffn) { rot = conv_mat_i8(arg_in(23), D, DFF, ws + WS_WGU, 1, sc[2], arg_in(22), scr, gw, NGW, rot, lane);
        rot = conv_mat_i8(arg_in(24), D, DFF, ws + WS_WGU, 2, sc[2], arg_in(22), scr, gw, NGW, rot, lane); }
    if (I8_OUTPROJ && proj) { rot = conv_mat_i8(arg_in(21), D, D, ws + WS_WOUT, 0, sc[3], nullptr, scr, gw, NGW, rot, lane);
        rot = conv_mat_i8(arg_in(21) + (size_t)D * D, D, D, ws + WS_WOUT + (size_t)D * D, 0, sc[4], nullptr, scr, gw, NGW, rot, lane); }
}
__device__ __forceinline__ float wscale(int t) { return __uint_as_float(__hip_atomic_load((const unsigned*)(arg_ws() + WS_CTL) + CW_WMAX + 64 * t, RLX_AGENT)) * (1.f / 127.f); }

__device__ __forceinline__ void rs_phase(int vcu, int G, int wv) {
    OPAQUE_TID(); OPAQUE_U(vcu); OPAQUE_U(G);
    const float* ss = (const float*)(arg_ws() + WS_SS); float* rd = (float*)(arg_ws() + WS_RD);
    for (int r = vcu * (NWAVES * 64) + tid; r < NTOK; r += G * NWAVES * 64) { const f32x4* p = (const f32x4*)(ss + (size_t)r * 16); const f32x4 a = p[0], b = p[1], c = p[2], d = p[3];
        const float t = (((a.x + a.y) + (a.z + a.w)) + ((b.x + b.y) + (b.z + b.w))) + (((c.x + c.y) + (c.z + c.w)) + ((d.x + d.y) + (d.z + d.w)));
        rd[r] = __builtin_amdgcn_rsqf(t * (1.f / D) + EPS); }
}
__device__ __forceinline__ void xq_phase(int vcu, int G, int wv) {
    OPAQUE_TID(); OPAQUE_U(vcu); OPAQUE_U(G);
    constexpr int XQR = 8;
    const int gw = vcu * NWAVES + wave, NGW = G * NWAVES;
    const bf16* xb = (const bf16*)(arg_ws() + WS_XB); unsigned char* xq = arg_ws() + WS_XQ; float* rs = (float*)(arg_ws() + WS_RS); float* rd = (float*)(arg_ws() + WS_RD);
    for (int m0 = XQR * gw; m0 < NTOK; m0 += XQR * NGW) {
        u32x2 b[XQR][4];
#pragma unroll
        for (int r = 0; r < XQR; ++r)
#pragma unroll
            for (int j = 0; j < 4; ++j) b[r][j] = ((const u32x2*)(xb + (size_t)(m0 + r) * D) + lane)[64 * j];
        float sq[XQR], mx[XQR];
#pragma unroll
        for (int r = 0; r < XQR; ++r) { sq[r] = 0.f; mx[r] = 0.f;
#pragma unroll
            for (int j = 0; j < 4; ++j) { const float x0 = bf_lo(b[r][j].x), x1 = bf_hi(b[r][j].x), x2 = bf_lo(b[r][j].y), x3 = bf_hi(b[r][j].y);
                sq[r] += (x0 * x0 + x1 * x1) + (x2 * x2 + x3 * x3); mx[r] = fmaxf(mx[r], fmaxf(fmaxf(fabsf(x0), fabsf(x1)), fmaxf(fabsf(x2), fabsf(x3)))); } }
#pragma unroll
        for (int r = 0; r < XQR; ++r) { sq[r] = wave_sum(sq[r]); mx[r] = wave_max(mx[r]); }
#pragma unroll
        for (int r = 0; r < XQR; ++r) { const float qs = mx[r] > 0.f ? 127.f / mx[r] : 0.f; unsigned* q4 = (unsigned*)(xq + (size_t)(m0 + r) * D) + lane;
#pragma unroll
            for (int j = 0; j < 4; ++j) q4[64 * j] = pk4_i8(bf_lo(b[r][j].x) * qs, bf_hi(b[r][j].x) * qs, bf_lo(b[r][j].y) * qs, bf_hi(b[r][j].y) * qs);
            if (lane == 0) { const float d = __builtin_amdgcn_rsqf(sq[r] * (1.f / D) + EPS); rs[m0 + r] = d * mx[r] * (1.f / 127.f); rd[m0 + r] = d; } }
    }
}
__device__ __forceinline__ void norm_router_phase(const float* g, const float* router, LAS unsigned char* lds, int G, int wv) {
    OPAQUE_TID(); OPAQUE_U(G);
    LAS int* lcnt = (LAS int*)(lds + 32768);
    LAS int* lbase = lcnt + 16;
    LAS int* rec_e = lcnt + 32;
    LAS int* rec_p = rec_e + 256;
    LAS float* rec_g = (LAS float*)(rec_p + 256);
    float Rr[4][8][4];
#pragma unroll
    for (int q = 0; q < 4; ++q)
#pragma unroll
        for (int c = 0; c < 4; ++c) { const f32x4* rp = (const f32x4*)(router + (size_t)(4 * lane + 256 * q + c) * NE); const f32x4 a = rp[0], b = rp[1];
            Rr[q][0][c] = a.x; Rr[q][1][c] = a.y; Rr[q][2][c] = a.z; Rr[q][3][c] = a.w; Rr[q][4][c] = b.x; Rr[q][5][c] = b.y; Rr[q][6][c] = b.z; Rr[q][7][c] = b.w; }
    gu32* ctl = (gu32*)(arg_ws() + WS_CTL);
    int* ltok = (int*)(arg_ws() + WS_LTOK); float* lgate = (float*)(arg_ws() + WS_LGATE);
    const bf16* xres = (const bf16*)(arg_ws() + WS_XB); unsigned char* xn8 = arg_ws() + WS_XN8;
    for (int ck = blockIdx.x; ck < NTOK / 128; ck += G) {
        if (tid < 16) lcnt[tid] = 0;
        __syncthreads();
        u32x2 nb[4];
#pragma unroll
        for (int q = 0; q < 4; ++q) nb[q] = ((const u32x2*)(xres + (size_t)(ck * 128 + wave * 16) * D) + lane)[64 * q];
        for (int j = 0; j < 16; ++j) {
            const int tl = wave * 16 + j, m = ck * 128 + tl;
            const f32x4* gr = (const f32x4*)g + lane;
            f32x4 v[4]; float s = 0.f;
#pragma unroll
            for (int q = 0; q < 4; ++q) { const u32x2 b = nb[q]; v[q] = (f32x4){bf_lo(b.x), bf_hi(b.x), bf_lo(b.y), bf_hi(b.y)}; s += (v[q].x * v[q].x + v[q].y * v[q].y) + (v[q].z * v[q].z + v[q].w * v[q].w); }
            if (j < 15) {
#pragma unroll
                for (int q = 0; q < 4; ++q) nb[q] = ((const u32x2*)(xres + (size_t)(m + 1) * D) + lane)[64 * q]; }
            const float rstd = __builtin_amdgcn_rsqf(wave_sum(s) * (1.f / D) + EPS);
            float lg[8];
#pragma unroll
            for (int e = 0; e < 8; ++e) lg[e] = 0.f;
            unsigned* o4 = (unsigned*)(xn8 + (size_t)m * D) + lane; const float s8 = (float)(1 << SC_XN8);
#pragma unroll
            for (int q = 0; q < 4; ++q) { const f32x4 gg = gr[64 * q]; f32x4 h; h.x = v[q].x * rstd * gg.x; h.y = v[q].y * rstd * gg.y; h.z = v[q].z * rstd * gg.z; h.w = v[q].w * rstd * gg.w;
                o4[64 * q] = pk4_fp8(s8 * h.x, s8 * h.y, s8 * h.z, s8 * h.w);
#pragma unroll
                for (int e = 0; e < 8; ++e) lg[e] += (h.x * Rr[q][e][0] + h.y * Rr[q][e][1]) + (h.z * Rr[q][e][2] + h.w * Rr[q][e][3]); }
#pragma unroll
            for (int e = 0; e < 8; ++e) lg[e] = wave_sum(lg[e]);
            int e0 = 0; float l0 = lg[0];
#pragma unroll
            for (int e = 1; e < 8; ++e) if (lg[e] > l0) { l0 = lg[e]; e0 = e; }
            int e1 = -1; float l1 = -INFINITY;
#pragma unroll
            for (int e = 0; e < 8; ++e) if (e != e0 && lg[e] > l1) { l1 = lg[e]; e1 = e; }
            if (lane == 0) { const float ex = __expf(l1 - l0); const float g0 = 1.f / (1.f + ex), g1 = ex / (1.f + ex);
                const int p0 = atomicAdd((int*)(lcnt + e0), 1), p1 = atomicAdd((int*)(lcnt + 8 + e1), 1);
                rec_e[2 * tl] = e0; rec_e[2 * tl + 1] = e1; rec_p[2 * tl] = p0; rec_p[2 * tl + 1] = p1; rec_g[2 * tl] = g0; rec_g[2 * tl + 1] = g1; }
        }
        __syncthreads();
        if (tid < 16) { const int c = lcnt[tid]; lbase[tid] = c ? (int)xb_add((unsigned*)(ctl + CW_MOECNT + 64 * tid), (unsigned)c) : 0; }
        __syncthreads();
        if (tid < 256) { const int tl = tid >> 1, k = tid & 1; const int e = rec_e[tid], li = k * 8 + e; const int pos = lbase[li] + rec_p[tid];
            ltok[(size_t)li * NTOK + pos] = ck * 128 + tl; lgate[(size_t)li * NTOK + pos] = rec_g[tid]; }
        __syncthreads();
    }
}

__device__ __forceinline__ void groupnorm_phase(const float* gg, int vcu, int G, int wv) {
    OPAQUE_TID(); OPAQUE_U(vcu); OPAQUE_U(G);
    const int gw = vcu * NWAVES + wave, NGW = G * NWAVES;
    f32x4 gv[4];
#pragma unroll
    for (int q = 0; q < 4; ++q) gv[q] = *(const f32x4*)(gg + 16 * lane + 4 * q);
    bf16* yb = (bf16*)(arg_ws() + WS_Y); unsigned char* yq = arg_ws() + WS_YQ; float* ysc = (float*)(arg_ws() + WS_YS);
    for (int m0 = 8 * gw; m0 < NTOK; m0 += 8 * NGW) {
        u32x4 w[8][2];
#pragma unroll
        for (int r = 0; r < 8; ++r) { const u32x4* p = (const u32x4*)(yb + (size_t)(m0 + r) * D + 16 * lane); w[r][0] = p[0]; w[r][1] = p[1]; }
#pragma unroll
        for (int r = 0; r < 8; ++r) {
            float v[16];
#pragma unroll
            for (int i = 0; i < 4; ++i) { v[2 * i] = bf_lo(w[r][0][i]); v[2 * i + 1] = bf_hi(w[r][0][i]); v[8 + 2 * i] = bf_lo(w[r][1][i]); v[8 + 2 * i + 1] = bf_hi(w[r][1][i]); }
            float s = 0.f;
#pragma unroll
            for (int i = 0; i < 16; ++i) s += v[i] * v[i];
            s += swz_xor<1>(s); s += swz_xor<2>(s); s += swz_xor<4>(s); s += swz_xor<8>(s);
            const float rstd = __builtin_amdgcn_rsqf(s * (1.f / 256.f) + EPS);
            float mx = 0.f;
#pragma unroll
            for (int i = 0; i < 16; ++i) { v[i] = v[i] * rstd * gv[i >> 2][i & 3]; mx = fmaxf(mx, fabsf(v[i])); }
            if (!I8_OUTPROJ) { u32x4 o0, o1;
#pragma unroll
                for (int i = 0; i < 4; ++i) { o0[i] = pk2(v[2 * i], v[2 * i + 1]); o1[i] = pk2(v[8 + 2 * i], v[8 + 2 * i + 1]); }
                u32x4* pw = (u32x4*)(yb + (size_t)(m0 + r) * D + 16 * lane); pw[0] = o0; pw[1] = o1; }
            else { mx = wave_max(mx); const float qs = mx > 0.f ? 127.f / mx : 0.f;
                u32x4 o; o.x = pk4_i8(v[0] * qs, v[1] * qs, v[2] * qs, v[3] * qs); o.y = pk4_i8(v[4] * qs, v[5] * qs, v[6] * qs, v[7] * qs);
                o.z = pk4_i8(v[8] * qs, v[9] * qs, v[10] * qs, v[11] * qs); o.w = pk4_i8(v[12] * qs, v[13] * qs, v[14] * qs, v[15] * qs);
                *(u32x4*)(yq + (size_t)(m0 + r) * D + 16 * lane) = o;
                if (lane == 0) ysc[m0 + r] = mx * (1.f / 127.f); }
        }
    }
}

constexpr int ATT_K_OFF = 0, ATT_KSTR = 144, ATT_V_OFF = 9216, ATT_VSTR = 136, ATT_DONE_OFF = 18432;
constexpr float ATT_THR = 64.0f;
__device__ __forceinline__ void attn_unit(int layer, int b, int h, int qb, LAS unsigned char* lds, int tid, int lane, int w) {
    const bf16* proj = (const bf16*)(arg_ws() + WS_PROJ);
    bf16* Y = (bf16*)(arg_ws() + WS_Y);
    const float* gq = arg_in(3) + layer * 64; const float* gk = arg_in(4) + layer * 64;
    const int r32 = lane & 31, hi = lane >> 5;
    const int tw0 = qb * 256 + 32 * w, tq = tw0 + r32;
    const size_t tokbase = (size_t)b * SEQ;
    bf16x8 qf[4];
    {
        const bf16* qrow = proj + (tokbase + tq) * INC + C_Q + h * 64 + 8 * hi;
        u32x4 raw[4]; float ss = 0.f;
#pragma unroll
        for (int kk = 0; kk < 4; ++kk) { raw[kk] = *(const u32x4*)(qrow + 16 * kk);
#pragma unroll
            for (int j = 0; j < 4; ++j) { const float x0 = bf_lo(raw[kk][j]), x1 = bf_hi(raw[kk][j]); ss += x0 * x0 + x1 * x1; } }
        ss = sum_halves(ss);
        const float sc = __builtin_amdgcn_rsqf(ss * (1.f / 64.f) + EPS) * (0.125f * LOG2E);
#pragma unroll
        for (int kk = 0; kk < 4; ++kk) { const f32x4 g0 = *(const f32x4*)(gq + 16 * kk + 8 * hi), g1 = *(const f32x4*)(gq + 16 * kk + 8 * hi + 4);
            u32x4 o; o.x = pk2(bf_lo(raw[kk].x) * sc * g0.x, bf_hi(raw[kk].x) * sc * g0.y); o.y = pk2(bf_lo(raw[kk].y) * sc * g0.z, bf_hi(raw[kk].y) * sc * g0.w);
            o.z = pk2(bf_lo(raw[kk].z) * sc * g1.x, bf_hi(raw[kk].z) * sc * g1.y); o.w = pk2(bf_lo(raw[kk].w) * sc * g1.z, bf_hi(raw[kk].w) * sc * g1.w);
            qf[kk] = __builtin_bit_cast(bf16x8, o); }
    }
    const int sr = tid >> 3, sc8 = tid & 7;
    const f32x4 gk0 = *(const f32x4*)(gk + 8 * sc8), gk1 = *(const f32x4*)(gk + 8 * sc8 + 4);
    f32x16 o0, o1;
#pragma unroll
    for (int i = 0; i < 16; ++i) { o0[i] = 0.f; o1[i] = 0.f; }
    float run = 0.f;
    LAS unsigned* done_cnt = (LAS unsigned*)(lds + ATT_DONE_OFF);
    bool wdone = false;
    if (tid == 0) *done_cnt = 0u;
    const int jt = 4 * qb + 3;
    u32x4 kq[3], vq[3];
#pragma unroll
    for (int d = 0; d < 3; ++d) { const bf16* p = proj + (tokbase + 64 * (jt - d) + sr) * INC + h * 64 + 8 * sc8; kq[d] = *(const u32x4*)(p + C_K); vq[d] = *(const u32x4*)(p + C_V); }
    auto step = [&](const int j, u32x4& kraw, u32x4& vraw) __attribute__((always_inline)) -> bool {
        {
            float kv[8];
#pragma unroll
            for (int i = 0; i < 4; ++i) { kv[2 * i] = bf_lo(kraw[i]); kv[2 * i + 1] = bf_hi(kraw[i]); }
            float ss = 0.f;
#pragma unroll
            for (int i = 0; i < 8; ++i) ss += kv[i] * kv[i];
            ss += swz_xor<1>(ss); ss += swz_xor<2>(ss); ss += swz_xor<4>(ss);
            const float rs = __builtin_amdgcn_rsqf(ss * (1.f / 64.f) + EPS);
            u32x4 o; o.x = pk2(kv[0] * rs * gk0.x, kv[1] * rs * gk0.y); o.y = pk2(kv[2] * rs * gk0.z, kv[3] * rs * gk0.w); o.z = pk2(kv[4] * rs * gk1.x, kv[5] * rs * gk1.y); o.w = pk2(kv[6] * rs * gk1.z, kv[7] * rs * gk1.w);
            *(LAS u32x4*)(lds + ATT_K_OFF + sr * ATT_KSTR + sc8 * 16) = o;
#pragma unroll
            for (int i = 0; i < 8; ++i) *(LAS unsigned short*)(lds + ATT_V_OFF + (8 * sc8 + i) * ATT_VSTR + sr * 2) = (unsigned short)((vraw[i >> 1] >> (16 * (i & 1))) & 0xffffu);
        }
        __syncthreads();
        if (j >= 3) { const bf16* p = proj + (tokbase + 64 * (j - 3) + sr) * INC + h * 64 + 8 * sc8; kraw = *(const u32x4*)(p + C_K); vraw = *(const u32x4*)(p + C_V); }
        if (!wdone && 64 * j <= tw0 + 30) {
            f32x16 p0, p1;
#pragma unroll
            for (int i = 0; i < 16; ++i) { p0[i] = 0.f; p1[i] = 0.f; }
#pragma unroll
            for (int kk = 0; kk < 4; ++kk) {
                const bf16x8 k0 = *(const LAS bf16x8*)(lds + ATT_K_OFF + r32 * ATT_KSTR + (16 * kk + 8 * hi) * 2);
                const bf16x8 k1 = *(const LAS bf16x8*)(lds + ATT_K_OFF + (32 + r32) * ATT_KSTR + (16 * kk + 8 * hi) * 2);
                p0 = __builtin_amdgcn_mfma_f32_32x32x16_bf16(k0, qf[kk], p0, 0, 0, 0);
                p1 = __builtin_amdgcn_mfma_f32_32x32x16_bf16(k1, qf[kk], p1, 0, 0, 0);
            }
            const bool diag = (64 * j + 63 >= tw0);
            float sp[2][16];
#pragma unroll
            for (int kb = 0; kb < 2; ++kb)
#pragma unroll
                for (int r = 0; r < 16; ++r) { const float z = kb ? p1[r] : p0[r];
                    float s = __builtin_amdgcn_logf(1.0f + __builtin_amdgcn_exp2f(z));
                    if (diag) { const int key = 64 * j + 32 * kb + (r & 3) + 8 * (r >> 2) + 4 * hi; if (key >= tq) s = 0.f; }
                    sp[kb][r] = s; }
            float Gt[2][4], Gh[2][4];
#pragma unroll
            for (int kb = 0; kb < 2; ++kb)
#pragma unroll
                for (int g = 0; g < 4; ++g) { const float gs = (sp[kb][4 * g] + sp[kb][4 * g + 1]) + (sp[kb][4 * g + 2] + sp[kb][4 * g + 3]); float lo, hh; halves(gs, lo, hh); Gt[kb][g] = lo + hh; Gh[kb][g] = hh; }
            float suf = run;
            u32x4 pw[4];
#pragma unroll
            for (int kb = 1; kb >= 0; --kb)
#pragma unroll
                for (int g = 3; g >= 0; --g) {
                    const float base = suf + (hi == 0 ? Gh[kb][g] : 0.f);
                    const float c3 = base + sp[kb][4 * g + 3], c2 = c3 + sp[kb][4 * g + 2], c1 = c2 + sp[kb][4 * g + 1], c0 = c1 + sp[kb][4 * g];
                    const float z0 = kb ? p1[4 * g] : p0[4 * g], z1 = kb ? p1[4 * g + 1] : p0[4 * g + 1], z2 = kb ? p1[4 * g + 2] : p0[4 * g + 2], z3 = kb ? p1[4 * g + 3] : p0[4 * g + 3];
                    float w0 = __builtin_amdgcn_exp2f(z0 - c0), w1 = __builtin_amdgcn_exp2f(z1 - c1), w2 = __builtin_amdgcn_exp2f(z2 - c2), w3 = __builtin_amdgcn_exp2f(z3 - c3);
                    if (diag) { const int key = 64 * j + 32 * kb + 8 * g + 4 * hi; if (key >= tq) w0 = 0.f; if (key + 1 >= tq) w1 = 0.f; if (key + 2 >= tq) w2 = 0.f; if (key + 3 >= tq) w3 = 0.f; }
                    const int ks = 2 * kb + (g >> 1);
                    if (g & 1) { pw[ks].z = pk2(w0, w1); pw[ks].w = pk2(w2, w3); } else { pw[ks].x = pk2(w0, w1); pw[ks].y = pk2(w2, w3); }
                    suf += Gt[kb][g];
                }
            run = suf;
            if (__all(run >= ATT_THR)) { wdone = true; if (lane == 0) atomicAdd((unsigned*)done_cnt, 1u); }
#pragma unroll
            for (int ks = 0; ks < 4; ++ks) {
                const bf16x8 pb = __builtin_bit_cast(bf16x8, pw[ks]);
#pragma unroll
                for (int db = 0; db < 2; ++db) {
                    const LAS unsigned char* vp = lds + ATT_V_OFF + (32 * db + r32) * ATT_VSTR + (16 * ks + 4 * hi) * 2;
                    const u32x2 lo = *(const LAS u32x2*)vp, hh = *(const LAS u32x2*)(vp + 16);
                    u32x4 av; av.x = lo.x; av.y = lo.y; av.z = hh.x; av.w = hh.y;
                    if (db == 0) o0 = __builtin_amdgcn_mfma_f32_32x32x16_bf16(__builtin_bit_cast(bf16x8, av), pb, o0, 0, 0, 0);
                    else o1 = __builtin_amdgcn_mfma_f32_32x32x16_bf16(__builtin_bit_cast(bf16x8, av), pb, o1, 0, 0, 0);
                }
            }
        }
        __syncthreads();
        return *done_cnt == 8u;
    };
    for (int j = jt; j >= 0; j -= 3) {
        if (step(j, kq[0], vq[0])) break;
        if (j < 1 || step(j - 1, kq[1], vq[1])) break;
        if (j < 2 || step(j - 2, kq[2], vq[2])) break;
    }
    __syncthreads();
    bf16* yrow = Y + (tokbase + tq) * D + h * 64 + 4 * hi;
#pragma unroll
    for (int g = 0; g < 4; ++g) {
        u32x2 s0; s0.x = pk2(o0[4 * g], o0[4 * g + 1]); s0.y = pk2(o0[4 * g + 2], o0[4 * g + 3]); *(u32x2*)(yrow + 8 * g) = s0;
        u32x2 s1; s1.x = pk2(o1[4 * g], o1[4 * g + 1]); s1.y = pk2(o1[4 * g + 2], o1[4 * g + 3]); *(u32x2*)(yrow + 32 + 8 * g) = s1;
    }
}
__device__ __forceinline__ void attn_phase(int layer, LAS unsigned char* lds, int G, int wv) {
    OPAQUE_TID(); OPAQUE_U(G); OPAQUE_U(layer);
    for (int i = blockIdx.x; i < 512; i += G) {
        const int idx = i < 256 ? i : 767 - i;
        const int qb = 7 - (idx >> 6), bh = idx & 63;
        attn_unit(layer, bh >> 2, bh & 3, qb, lds, tid, lane, wave);
    }
}

constexpr int CF_H_OFF = 0, CF_Y_OFF = 81920;
__device__ __forceinline__ void conf_unit(int layer, int b, int c, LAS unsigned char* lds, int tid, int lane, int w) {
    const bf16* proj = (const bf16*)(arg_ws() + WS_PROJ);
    bf16* Y = (bf16*)(arg_ws() + WS_Y);
    const size_t tokbase = (size_t)b * SEQ; const int t0 = 128 * c;
    { const int cq = tid & 31, rr = tid >> 5;
#pragma unroll
      for (int hb = 0; hb < 2; ++hb) {
          u32x4 vv[5], gg[5];
#pragma unroll
          for (int ps = 0; ps < 5; ++ps) { const int i = (5 * hb + ps) * 16 + rr, pos = t0 - 30 + i; vv[ps] = (u32x4){0u, 0u, 0u, 0u}; gg[ps] = vv[ps];
              if (i < 158 && pos >= 0) { const bf16* p = proj + (tokbase + pos) * INC + 8 * cq; vv[ps] = *(const u32x4*)(p + C_CV); gg[ps] = *(const u32x4*)(p + C_CG); } }
#pragma unroll
          for (int ps = 0; ps < 5; ++ps) { const int i = (5 * hb + ps) * 16 + rr; u32x4 o;
#pragma unroll
              for (int q = 0; q < 4; ++q) o[q] = pk2(bf_lo(vv[ps][q]) * fast_sigmoid(bf_lo(gg[ps][q])), bf_hi(vv[ps][q]) * fast_sigmoid(bf_hi(gg[ps][q])));
              if (i < 158) *(LAS u32x4*)(lds + CF_H_OFF + i * 512 + cq * 16) = o; } } }
    __syncthreads();
    const int cp = tid & 127, tg = tid >> 7;
    const float* cw = arg_in(5) + (size_t)layer * 31 * 256 + 2 * cp;
    float w0[31], w1[31];
#pragma unroll
    for (int k = 0; k < 31; ++k) { const f32x2 t = *(const f32x2*)(cw + k * 256); w0[k] = t.x; w1[k] = t.y; }
    const f32x2 cb = *(const f32x2*)(arg_in(6) + layer * 256 + 2 * cp);
    const f32x4 lg = *(const f32x4*)(arg_in(7) + layer * 256 + 4 * lane), lb = *(const f32x4*)(arg_in(8) + layer * 256 + 4 * lane);
    for (int ps = 0; ps < 4; ++ps) {
        const int tl0 = 32 * ps + 8 * tg;
        float a0[8], a1[8];
#pragma unroll
        for (int o = 0; o < 8; ++o) { a0[o] = cb.x; a1[o] = cb.y; }
#pragma unroll
        for (int q = 0; q < 38; ++q) { const unsigned dw = *(const LAS unsigned*)(lds + CF_H_OFF + (tl0 + q) * 512 + cp * 4); const float x0 = bf_lo(dw), x1 = bf_hi(dw);
#pragma unroll
            for (int o = 0; o < 8; ++o) { if (q - o >= 0 && q - o <= 30) { a0[o] += w0[q - o] * x0; a1[o] += w1[q - o] * x1; } } }
#pragma unroll
        for (int o = 0; o < 8; ++o) *(LAS f32x2*)(lds + CF_Y_OFF + ((8 * tg + o) * 256 + 2 * cp) * 4) = (f32x2){a0[o], a1[o]};
        __syncthreads();
#pragma unroll
        for (int r = 0; r < 4; ++r) { const int row = 4 * w + r; const f32x4 v = *(const LAS f32x4*)(lds + CF_Y_OFF + (row * 256 + 4 * lane) * 4);
            const float mean = wave_sum((v.x + v.y) + (v.z + v.w)) * (1.f / 256.f);
            const f32x4 d = v - mean; const float var = wave_sum((d.x * d.x + d.y * d.y) + (d.z * d.z + d.w * d.w)) * (1.f / 256.f);
            const float rstd = __builtin_amdgcn_rsqf(var + EPS);
            f32x4 y = d * rstd * lg + lb;
            y.x *= fast_sigmoid(y.x); y.y *= fast_sigmoid(y.y); y.z *= fast_sigmoid(y.z); y.w *= fast_sigmoid(y.w);
            u32x2 o; o.x = pk2(y.x, y.y); o.y = pk2(y.z, y.w);
            *(u32x2*)(Y + (tokbase + t0 + 32 * ps + row) * D + 256 + 4 * lane) = o; }
        __syncthreads();
    }
}
__device__ __forceinline__ void conf_phase(int layer, LAS unsigned char* lds, int G, int wv) {
    OPAQUE_TID(); OPAQUE_U(G); OPAQUE_U(layer);
    for (int i = blockIdx.x; i < 256; i += G) conf_unit(layer, i >> 4, i & 15, lds, tid, lane, wave);
}

constexpr int GM_U_OFF = 0, GM_USTR = 520, GM_V_OFF = 66560, GM_VSTR = 272;
__device__ __forceinline__ void gmlp_unit(int layer, int b, int c, LAS unsigned char* lds, int tid, int lane, int w) {
    const bf16* proj = (const bf16*)(arg_ws() + WS_PROJ);
    bf16* Y = (bf16*)(arg_ws() + WS_Y);
    const size_t tokbase = (size_t)b * SEQ; const int t0 = 128 * c;
    const f32x4 lg = *(const f32x4*)(arg_in(9) + layer * 256 + 4 * lane), lb = *(const f32x4*)(arg_in(10) + layer * 256 + 4 * lane);
    u32x2 urs[16], vrs[16];
#pragma unroll
    for (int j = 0; j < 16; ++j) { const bf16* p = proj + (tokbase + t0 + 16 * w + j) * INC + 4 * lane; urs[j] = *(const u32x2*)(p + C_GU); vrs[j] = *(const u32x2*)(p + C_GV); }
#pragma unroll
    for (int j = 0; j < 16; ++j) { const int t = 16 * w + j;
        const u32x2 ur = urs[j], vr = vrs[j];
        u32x2 uo; uo.x = pk2(gelu_tanh(bf_lo(ur.x)), gelu_tanh(bf_hi(ur.x))); uo.y = pk2(gelu_tanh(bf_lo(ur.y)), gelu_tanh(bf_hi(ur.y)));
        *(LAS u32x2*)(lds + GM_U_OFF + t * GM_USTR + lane * 8) = uo;
        f32x4 v; v.x = gelu_tanh(bf_lo(vr.x)); v.y = gelu_tanh(bf_hi(vr.x)); v.z = gelu_tanh(bf_lo(vr.y)); v.w = gelu_tanh(bf_hi(vr.y));
        const float mean = wave_sum((v.x + v.y) + (v.z + v.w)) * (1.f / 256.f);
        const f32x4 d = v - mean; const float var = wave_sum((d.x * d.x + d.y * d.y) + (d.z * d.z + d.w * d.w)) * (1.f / 256.f);
        const float rstd = __builtin_amdgcn_rsqf(var + EPS);
        const f32x4 y = d * rstd * lg + lb;
        const unsigned q0 = pk2(y.x, y.y), q1 = pk2(y.z, y.w);
        LAS unsigned char* vp = lds + GM_V_OFF + (4 * lane) * GM_VSTR + t * 2;
        *(LAS unsigned short*)(vp) = (unsigned short)(q0 & 0xffffu); *(LAS unsigned short*)(vp + GM_VSTR) = (unsigned short)(q0 >> 16);
        *(LAS unsigned short*)(vp + 2 * GM_VSTR) = (unsigned short)(q1 & 0xffffu); *(LAS unsigned short*)(vp + 3 * GM_VSTR) = (unsigned short)(q1 >> 16); }
    __syncthreads();
    const int fr = lane & 15, fq = lane >> 4, t = 16 * w + fr;
    const int nks = (w >> 1) + 1;
    const bf16* wm = (const bf16*)(arg_ws() + WS_GWM) + (size_t)layer * 4 * 128 * 128;
    const float* bs = arg_in(12) + layer * 4 * 128;
#pragma unroll
    for (int h = 0; h < 4; ++h) {
        bf16x8 bfr[4];
#pragma unroll
        for (int ks = 0; ks < 4; ++ks) { if (ks < nks) bfr[ks] = *(const bf16x8*)(wm + ((size_t)h * 128 + t) * 128 + 32 * ks + 8 * fq); else bfr[ks] = (bf16x8){0, 0, 0, 0, 0, 0, 0, 0}; }
        const float bsv = bs[h * 128 + t];
#pragma unroll
        for (int dt = 0; dt < 4; ++dt) {
            f32x4 acc = (f32x4){0.f, 0.f, 0.f, 0.f};
#pragma unroll
            for (int ks = 0; ks < 4; ++ks) { if (ks < nks) { const bf16x8 af = *(const LAS bf16x8*)(lds + GM_V_OFF + (64 * h + 16 * dt + fr) * GM_VSTR + (32 * ks + 8 * fq) * 2);
                    acc = __builtin_amdgcn_mfma_f32_16x16x32_bf16(af, bfr[ks], acc, 0, 0, 0); } }
            const u32x2 uu = *(const LAS u32x2*)(lds + GM_U_OFF + t * GM_USTR + (64 * h + 16 * dt + 4 * fq) * 2);
            u32x2 o; o.x = pk2(bf_lo(uu.x) * (acc[0] + bsv), bf_hi(uu.x) * (acc[1] + bsv)); o.y = pk2(bf_lo(uu.y) * (acc[2] + bsv), bf_hi(uu.y) * (acc[3] + bsv));
            *(u32x2*)(Y + (tokbase + t0 + t) * D + 512 + 64 * h + 16 * dt + 4 * fq) = o;
        }
    }
    __syncthreads();
}
__device__ __forceinline__ void gmlp_phase(int layer, LAS unsigned char* lds, int G, int wv) {
    OPAQUE_TID(); OPAQUE_U(G); OPAQUE_U(layer);
    for (int i = blockIdx.x; i < 256; i += G) gmlp_unit(layer, i >> 4, i & 15, lds, tid, lane, wave);
}

constexpr int LR_R0 = 0;
constexpr int LR_XB = 37376;
constexpr int LR_XF = 74240;
constexpr int LR_GT = 90624;
constexpr int LR_YO = 109056;
__device__ __forceinline__ int lr_sw(int t) { return t + (t >> 3); }
__device__ __forceinline__ void lru_unit(int layer, int b, int h, int qt, LAS unsigned char* lds, int tid, int lane, int w) {
    const bf16* proj = (const bf16*)(arg_ws() + WS_PROJ);
    bf16* Y = (bf16*)(arg_ws() + WS_Y);
    const size_t tokbase = (size_t)b * SEQ;
    const int chb = 64 * h;
    const int c8 = tid & 7, tr = tid >> 3;
    const int fr = lane & 15, fq = lane >> 4;
    float cwo[4][4], cbo[4];
    { const float* cwp = arg_in(13) + (size_t)layer * 4 * 256 + chb + 16 * qt + 4 * fq;
#pragma unroll
      for (int k = 0; k < 4; ++k) { const f32x4 x = *(const f32x4*)(cwp + k * 256); cwo[k][0] = x.x; cwo[k][1] = x.y; cwo[k][2] = x.z; cwo[k][3] = x.w; }
      const f32x4 y = *(const f32x4*)(arg_in(14) + layer * 256 + chb + 16 * qt + 4 * fq); cbo[0] = y.x; cbo[1] = y.y; cbo[2] = y.z; cbo[3] = y.w; }
    bf16x8 afa[4][2], afx[4][2];
    float pa = 0.f, px = 0.f;
    { const bf16* wat = (const bf16*)(arg_ws() + WS_WAT) + ((size_t)(layer * 4 + h) * 64 + 16 * qt + fr) * 64 + 8 * fq;
      const bf16* wxt = (const bf16*)(arg_ws() + WS_WXT) + ((size_t)(layer * 4 + h) * 64 + 16 * qt + fr) * 64 + 8 * fq;
#pragma unroll
      for (int ks = 0; ks < 2; ++ks) { const u32x4 ra = *(const u32x4*)(wat + 32 * ks), rx = *(const u32x4*)(wxt + 32 * ks);
          float fa[8], fx[8];
#pragma unroll
          for (int e = 0; e < 4; ++e) { fa[2 * e] = bf_lo(ra[e]); fa[2 * e + 1] = bf_hi(ra[e]); fx[2 * e] = bf_lo(rx[e]); fx[2 * e + 1] = bf_hi(rx[e]); }
          const float* cbp = arg_in(14) + layer * 256 + chb + 32 * ks + 8 * fq; const f32x4 c0 = *(const f32x4*)cbp, c1 = *(const f32x4*)(cbp + 4);
          pa += (fa[0] * c0.x + fa[1] * c0.y) + (fa[2] * c0.z + fa[3] * c0.w) + (fa[4] * c1.x + fa[5] * c1.y) + (fa[6] * c1.z + fa[7] * c1.w);
          px += (fx[0] * c0.x + fx[1] * c0.y) + (fx[2] * c0.z + fx[3] * c0.w) + (fx[4] * c1.x + fx[5] * c1.y) + (fx[6] * c1.z + fx[7] * c1.w);
#pragma unroll
          for (int k = 0; k < 4; ++k) { const float* cwp = arg_in(13) + (size_t)layer * 4 * 256 + k * 256 + chb + 32 * ks + 8 * fq; const f32x4 w0 = *(const f32x4*)cwp, w1 = *(const f32x4*)(cwp + 4);
              u32x4 oa, ox;
              oa.x = pk2(fa[0] * w0.x, fa[1] * w0.y); oa.y = pk2(fa[2] * w0.z, fa[3] * w0.w); oa.z = pk2(fa[4] * w1.x, fa[5] * w1.y); oa.w = pk2(fa[6] * w1.z, fa[7] * w1.w);
              ox.x = pk2(fx[0] * w0.x, fx[1] * w0.y); ox.y = pk2(fx[2] * w0.z, fx[3] * w0.w); ox.z = pk2(fx[4] * w1.x, fx[5] * w1.y); ox.w = pk2(fx[6] * w1.z, fx[7] * w1.w);
              afa[k][ks] = __builtin_bit_cast(bf16x8, oa); afx[k][ks] = __builtin_bit_cast(bf16x8, ox); } } }
    pa = sum_rows16(pa); pa = sum_halves(pa); px = sum_rows16(px); px = sum_halves(px);
    LAS float* bsh = (LAS float*)(lds + LR_YO);
    if (w == 0 && fq == 0) { bsh[fr] = pa; bsh[16 + fr] = px; }
    __syncthreads();
    float bav[4], bxv[4], clv[4];
    { const int ch = layer * 256 + chb + 16 * qt + 4 * fq; const f32x4 x0 = *(const f32x4*)(arg_in(16) + ch), x1 = *(const f32x4*)(arg_in(18) + ch), x2 = *(const f32x4*)(arg_in(19) + ch);
#pragma unroll
      for (int i = 0; i < 4; ++i) { bav[i] = x0[i] + bsh[4 * fq + i]; bxv[i] = x1[i] + bsh[16 + 4 * fq + i]; clv[i] = -8.0f * log1pf(expf(-x2[i])); } }
    const int sc = 2 * w + (lane >> 5), sg = lane & 31;
    float hc = 0.f;
    u32x4 xpre[5], gpre;
#define LR_FETCH(P0) do { _Pragma("unroll") for (int ps = 0; ps < 5; ++ps) { const int i = 64 * ps + tr; const int pos = (P0) - 3 + i; xpre[ps] = (u32x4){0u, 0u, 0u, 0u}; \
            if (i < 259 && pos >= 0) xpre[ps] = *(const u32x4*)(proj + (tokbase + pos) * INC + C_LX + chb + 8 * c8); } \
        gpre = *(const u32x4*)(proj + (tokbase + (P0) + (tid >> 1)) * INC + C_LG + chb + 16 * qt + 8 * (tid & 1)); } while (0)
    LR_FETCH(0);
    for (int it = 0; it < 8; ++it) {
        const int p0 = 256 * it;
#pragma unroll
        for (int ps = 0; ps < 5; ++ps) { const int i = 64 * ps + tr; if (i < 259) *(LAS u32x4*)(lds + LR_R0 + i * 144 + c8 * 16) = xpre[ps]; }
        { const int t = tid >> 1, hf = tid & 1; const u32x4 gr = gpre;
          LAS float* gt = (LAS float*)(lds + LR_GT) + lr_sw(t);
#pragma unroll
          for (int i = 0; i < 4; ++i) { gt[(8 * hf + 2 * i) * 288] = gelu_tanh(bf_lo(gr[i])); gt[(8 * hf + 2 * i + 1) * 288] = gelu_tanh(bf_hi(gr[i])); } }
        __syncthreads();
        if (it < 7) LR_FETCH(p0 + 256);
#pragma unroll
        for (int tt = 0; tt < 2; ++tt) { const int t = 32 * w + 16 * tt + fr;
            f32x4 ca = (f32x4){0.f, 0.f, 0.f, 0.f}, cx = (f32x4){0.f, 0.f, 0.f, 0.f};
            float xf[4];
#pragma unroll
            for (int i = 0; i < 4; ++i) xf[i] = cbo[i];
#pragma unroll
            for (int k = 0; k < 4; ++k) {
#pragma unroll
                for (int ks = 0; ks < 2; ++ks) { const bf16x8 bfr = *(const LAS bf16x8*)(lds + LR_R0 + (t + k) * 144 + (32 * ks + 8 * fq) * 2);
                    ca = __builtin_amdgcn_mfma_f32_16x16x32_bf16(afa[k][ks], bfr, ca, 0, 0, 0); cx = __builtin_amdgcn_mfma_f32_16x16x32_bf16(afx[k][ks], bfr, cx, 0, 0, 0); }
                const u32x2 r = *(const LAS u32x2*)(lds + LR_R0 + (t + k) * 144 + (16 * qt + 4 * fq) * 2);
                xf[0] += cwo[k][0] * bf_lo(r.x); xf[1] += cwo[k][1] * bf_hi(r.x); xf[2] += cwo[k][2] * bf_lo(r.y); xf[3] += cwo[k][3] * bf_hi(r.y); }
            LAS float* aa = (LAS float*)(lds + LR_XB) + lr_sw(t); LAS float* bb = (LAS float*)(lds + LR_XB + 18432) + lr_sw(t);
#pragma unroll
            for (int i = 0; i < 4; ++i) { const float r = fast_sigmoid(ca[i] + bav[i]), ig = fast_sigmoid(cx[i] + bxv[i]); const float la = r * clv[i];
                aa[(4 * fq + i) * 288] = __expf(la); bb[(4 * fq + i) * 288] = __builtin_amdgcn_sqrtf(one_minus_exp(2.0f * la)) * ig * xf[i]; } }
        __syncthreads();
        { const LAS float* aa = (const LAS float*)(lds + LR_XB) + sc * 288; const LAS float* bb = (const LAS float*)(lds + LR_XB + 18432) + sc * 288;
          const LAS float* gt = (const LAS float*)(lds + LR_GT) + sc * 288; LAS float* yo = (LAS float*)(lds + LR_YO) + sc * 288;
          float av[8], bv[8]; float A = 1.f, B = 0.f;
#pragma unroll
          for (int k = 0; k < 8; ++k) { av[k] = aa[9 * sg + k]; bv[k] = bb[9 * sg + k]; B = av[k] * B + bv[k]; A *= av[k]; }
#define LR_SHFL(v, srclane) __int_as_float(__builtin_amdgcn_ds_bpermute((srclane) * 4, __float_as_int(v)))
#pragma unroll
          for (int off = 1; off < 32; off <<= 1) { const int src = sg >= off ? lane - off : lane; const float Ap = LR_SHFL(A, src), Bp = LR_SHFL(B, src); if (sg >= off) { B = A * Bp + B; A = Ap * A; } }
          float Ae = LR_SHFL(A, sg ? lane - 1 : lane), Be = LR_SHFL(B, sg ? lane - 1 : lane); if (sg == 0) { Ae = 1.f; Be = 0.f; }
          float hcur = Ae * hc + Be;
          const float At = LR_SHFL(A, lane | 31), Bt = LR_SHFL(B, lane | 31);
#undef LR_SHFL
          hc = At * hc + Bt;
#pragma unroll
          for (int k = 0; k < 8; ++k) { hcur = av[k] * hcur + bv[k]; yo[9 * sg + k] = hcur * gt[9 * sg + k]; } }
        __syncthreads();
        { const int t = tid >> 1, hf = tid & 1; const LAS float* yo = (const LAS float*)(lds + LR_YO) + lr_sw(t) + (8 * hf) * 288;
          u32x4 o; o.x = pk2(yo[0], yo[288]); o.y = pk2(yo[2 * 288], yo[3 * 288]); o.z = pk2(yo[4 * 288], yo[5 * 288]); o.w = pk2(yo[6 * 288], yo[7 * 288]);
          *(u32x4*)(Y + (tokbase + p0 + t) * D + 768 + chb + 16 * qt + 8 * hf) = o; }
    }
    __syncthreads();
}
#undef LR_FETCH
__device__ __forceinline__ void lru_phase(int layer, LAS unsigned char* lds, int G, int wv) {
    OPAQUE_TID(); OPAQUE_U(G); OPAQUE_U(layer);
    for (int i = blockIdx.x; i < 256; i += G) lru_unit(layer, i >> 4, (i >> 2) & 3, i & 3, lds, tid, lane, wave);
}

constexpr int N_PHASES = 25;
__device__ __forceinline__ void moe_table(LAS unsigned char* lds, int wv) {
    OPAQUE_TID();
    LAS int* tab = (LAS int*)(lds + MOE_TAB);
    if (tid < 16) { gu32* ctl = (gu32*)(arg_ws() + WS_CTL); const int c = (int)__hip_atomic_load(ctl + CW_MOECNT + 64 * tid, RLX_AGENT); tab[tid] = c; tab[40 + tid] = (c + 255) >> 8; }
    __syncthreads();
    if (tid < 17) { int accu = 0; for (int j = 0; j < tid; ++j) accu += tab[40 + j]; tab[16 + tid] = accu; }
    __syncthreads();
}
__device__ __forceinline__ void moe_gather_phase(LAS unsigned char* lds, int vcu, int G, int wv) {
    OPAQUE_TID(); OPAQUE_U(vcu); OPAQUE_U(G);
    moe_table(lds, wv);
    const int gw = vcu * NWAVES + wave, NGW = G * NWAVES;
    const unsigned char* xn8 = arg_ws() + WS_XN8; unsigned char* xg = arg_ws() + WS_XG8; const int* ltok = (const int*)(arg_ws() + WS_LTOK);
    const LAS int* tab = (const LAS int*)(lds + MOE_TAB);
    const int nrows = tab[32] * 256;
    for (int r0 = 8 * gw; r0 < nrows; r0 += 8 * NGW) {
        const int pm = r0 >> 8; int se = 0;
#pragma unroll
        for (int j = 1; j < 16; ++j) se += (pm >= tab[16 + j]) ? 1 : 0;
        const int p0 = r0 - tab[16 + se] * 256, cnt = tab[se];
        int tok[8]; u32x4 v[8];
#pragma unroll
        for (int i = 0; i < 8; ++i) tok[i] = (p0 + i) < cnt ? ltok[(size_t)se * NTOK + p0 + i] : NTOK;
#pragma unroll
        for (int i = 0; i < 8; ++i) v[i] = *(const u32x4*)(xn8 + (size_t)tok[i] * D + 16 * lane);
#pragma unroll
        for (int i = 0; i < 8; ++i) *(u32x4*)(xg + (size_t)(r0 + i) * D + 16 * lane) = v[i];
    }
}
__global__ void __launch_bounds__(NWAVES * 64, 2) fwd_kernel(Args args) {
    extern __shared__ __attribute__((aligned(16))) unsigned char lds_raw[];
    LAS unsigned char* lds = (LAS unsigned char*)lds_raw;
    const int wv = __builtin_amdgcn_readfirstlane((int)threadIdx.x >> 6);
    const int G_ = gridDim.x; const int bx_ = blockIdx.x; const int vcu_ = (G_ % 8 == 0) ? (bx_ % 8) * (G_ / 8) + bx_ / 8 : bx_;
#define G opq_s(G_)
#define bx opq_s(bx_)
#define vcu opq_s(vcu_)
    gu32* ctl = (gu32*)(arg_ws() + WS_CTL);
    for (int u = threadIdx.x; u < (LDS_BYTES - LDSCTL_OFF) / 4; u += NWAVES * 64) ((LAS unsigned*)(lds + LDSCTL_OFF))[u] = 0u;
    __syncthreads();
#if !MK_MULTI
    (void)xcd_barrier_post((unsigned*)(ctl + CW_BAR), (volatile LAS unsigned*)(lds + LDSCTL_OFF), threadIdx.x == 0);
#define GRID_BAR() do { XcdBarrier b_; b_.bar = (unsigned*)((gu32*)(arg_ws() + WS_CTL) + CW_BAR); b_.x = xb_xcc_id(); b_.st = (volatile LAS unsigned*)(lds + LDSCTL_OFF); xcd_barrier(b_, wv == 0 && lane_id() == 0); } while (0)
#else
#define GRID_BAR() do { } while (0)
#endif
    const int lo = args.ph_lo, hi = args.ph_hi;
#ifndef SITE_MASK
#define SITE_MASK 0xFFFF
#endif
#define SITE(n) constexpr (((SITE_MASK) >> (n)) & 1)
#define IN(k) (opq_s(lo) <= (k) && (k) < opq_s(hi))
#define SEAM(k) do { if (IN(k) && IN((k) + 1)) GRID_BAR(); } while (0)
    if SITE(0) if (IN(0)) { p0_prologue(lds, vcu, G, wv); }
    SEAM(0);
    if SITE(0) if (IN(1)) { if (I8_INPROJ || I8_OUTPROJ) p1_weights_i8(lds, vcu, G, wv, true, false); }
    if (I8_INPROJ || I8_OUTPROJ) SEAM(1);
    for (int L = 0; L < 2; ++L) {
        const int pb = 2 + 11 * L;
        if SITE(1) if (IN(pb + 0)) {
#if I8_INPROJ
            pg8::DenseOrder S; S.init(arg_ws() + WS_XQ, arg_ws() + WS_WIN + (size_t)L * INC * D, NTOK, INC, D / 2, G, bx);
            pg8::EpiBf16 E{(bf16*)(arg_ws() + WS_PROJ), INC, (const float*)(arg_ws() + WS_RS), wscale(L)};
            pg8::gemm_phase<pg8::EpiBf16, pg8::DenseOrder, -1, -1, true>(lds, D / 2, S, E, wv);
#else
            pg8::DenseOrder S; S.init(arg_ws() + WS_XB, arg_ws() + WS_WIN + (size_t)L * INC * D * 2, NTOK, INC, D, G, bx);
            pg8::EpiBf16 E{(bf16*)(arg_ws() + WS_PROJ), INC, (const float*)(arg_ws() + WS_RD), 1.f};
            pg8::gemm_phase<pg8::EpiBf16, pg8::DenseOrder>(lds, D, S, E, wv);
#endif
        }
        SEAM(pb + 0);
        if SITE(2) if (IN(pb + 1)) { attn_phase(L, lds, G, wv); __syncthreads(); }
        if SITE(3) if (IN(pb + 2)) { conf_phase(L, lds, G, wv); __syncthreads(); }
        if SITE(4) if (IN(pb + 3)) { gmlp_phase(L, lds, G, wv); __syncthreads(); }
        if SITE(5) if (IN(pb + 4)) { lru_phase(L, lds, G, wv); __syncthreads(); }
        SEAM(pb + 4);
        if SITE(6) if (IN(pb + 5)) { groupnorm_phase(arg_in(20) + L * D, vcu, G, wv); if (I8_FFN1 && L == 0) { __syncthreads(); p1_weights_i8(lds, vcu, G, wv, false, true); } }
        SEAM(pb + 5);
        if (L == 0) {
            if SITE(7) if (IN(pb + 6)) {
#if I8_OUTPROJ
                pg8::DenseOrder S; S.init(arg_ws() + WS_YQ, arg_ws() + WS_WOUT, NTOK, D, D / 2, G, bx);
                pg8::EpiResB<true, true> E{arg_in(0), (bf16*)(arg_ws() + WS_XB), (const float*)(arg_ws() + WS_YS), wscale(3), nullptr};
                pg8::gemm_phase<pg8::EpiResB<true, true>, pg8::DenseOrder, -1, -1, true>(lds, D / 2, S, E, wv);
#else
                pg8::DenseOrder S; S.init(arg_ws() + WS_Y, arg_ws() + WS_WOUT, NTOK, D, D, G, bx);
                pg8::EpiResB<false, false, !I8_FFN1> E{nullptr, (bf16*)(arg_ws() + WS_XB), nullptr, 1.f, (float*)(arg_ws() + WS_SS)};
                pg8::gemm_phase<pg8::EpiResB<false, false, !I8_FFN1>, pg8::DenseOrder>(lds, D, S, E, wv);
#endif
            }
            SEAM(pb + 6);
            if SITE(8) if (IN(pb + 7)) { if (I8_FFN1) xq_phase(vcu, G, wv); else rs_phase(vcu, G, wv); }
            SEAM(pb + 7);
            if SITE(10) if (IN(pb + 8)) {
#if I8_FFN1
                pg8::DenseOrder S; S.init(arg_ws() + WS_XQ, arg_ws() + WS_WGU, NTOK, 2 * DFF, D / 2, G, bx);
#if F8_FFN2
                pg8::EpiSwiGLUF8 E{arg_ws() + WS_HID, DFF, (const float*)(arg_ws() + WS_RS), wscale(2)};
                pg8::gemm_phase<pg8::EpiSwiGLUF8, pg8::DenseOrder, -1, -1, true>(lds, D / 2, S, E, wv);
#else
                pg8::EpiSwiGLU E{(bf16*)(arg_ws() + WS_HID), DFF, (const float*)(arg_ws() + WS_RS), wscale(2)};
                pg8::gemm_phase<pg8::EpiSwiGLU, pg8::DenseOrder, -1, -1, true>(lds, D / 2, S, E, wv);
#endif
#else
                pg8::DenseOrder S; S.init(arg_ws() + WS_XB, arg_ws() + WS_WGU, NTOK, 2 * DFF, D, G, bx);
                pg8::EpiSwiGLU E{(bf16*)(arg_ws() + WS_HID), DFF, (const float*)(arg_ws() + WS_RD), 1.f};
                pg8::gemm_phase<pg8::EpiSwiGLU, pg8::DenseOrder>(lds, D, S, E, wv);
#endif
            }
            SEAM(pb + 8);
            if SITE(11) if (IN(pb + 9)) {
#if F8_FFN2
                pg8::DenseOrder S; S.init(arg_ws() + WS_HID, arg_ws() + WS_WD, NTOK, D, DFF / 2, G, bx);
                pg8::EpiResB<false, false, !I8_INPROJ> E{nullptr, (bf16*)(arg_ws() + WS_XB), nullptr, 1.f, (float*)(arg_ws() + WS_SS)};
                pg8::gemm_phase<pg8::EpiResB<false, false, !I8_INPROJ>, pg8::DenseOrder, 127 - SC_HID8, 127 - SC_WD8>(lds, DFF / 2, S, E, wv);
#else
                pg8::DenseOrder S; S.init(arg_ws() + WS_HID, arg_ws() + WS_WD, NTOK, D, DFF, G, bx);
                pg8::EpiResB<false, false, !I8_INPROJ> E{nullptr, (bf16*)(arg_ws() + WS_XB), nullptr, 1.f, (float*)(arg_ws() + WS_SS)};
                pg8::gemm_phase<pg8::EpiResB<false, false, !I8_INPROJ>, pg8::DenseOrder>(lds, DFF, S, E, wv);
#endif
            }
            SEAM(pb + 9);
            if SITE(8) if (IN(pb + 10)) { if (I8_INPROJ) xq_phase(vcu, G, wv); else rs_phase(vcu, G, wv); }
            SEAM(pb + 10);
        } else {
            if SITE(15) if (IN(pb + 6)) {
#if I8_OUTPROJ
                pg8::DenseOrder S; S.init(arg_ws() + WS_YQ, arg_ws() + WS_WOUT + (size_t)D * D, NTOK, D, D / 2, G, bx);
                pg8::EpiResB<false, true> E{nullptr, (bf16*)(arg_ws() + WS_XB), (const float*)(arg_ws() + WS_YS), wscale(4), nullptr};
                pg8::gemm_phase<pg8::EpiResB<false, true>, pg8::DenseOrder, -1, -1, true>(lds, D / 2, S, E, wv);
#else
                pg8::DenseOrder S; S.init(arg_ws() + WS_Y, arg_ws() + WS_WOUT + (size_t)D * D * 2, NTOK, D, D, G, bx);
                pg8::EpiResB<false, false> E{nullptr, (bf16*)(arg_ws() + WS_XB), nullptr, 1.f, nullptr};
                pg8::gemm_phase<pg8::EpiResB<false, false>, pg8::DenseOrder>(lds, D, S, E, wv);
#endif
            }
            SEAM(pb + 6);
            if SITE(9) if (IN(pb + 7)) norm_router_phase(arg_in(22) + D, arg_in(26), lds, G, wv);
            SEAM(pb + 7);
            if SITE(14) if (IN(pb + 8)) { moe_gather_phase(lds, vcu, G, wv); __syncthreads(); }
            SEAM(pb + 8);
#pragma clang loop unroll(disable)
            for (int st = 0; st < 3; ++st) {
                if (IN(pb + 9 + st)) {
                    moe_table(lds, wv);
                    int hv = 0;
                    if SITE(13) if (st >= 1) {
                        const int slot = st - 1;
                        pg8::MoeOrder<8> S; S.init(arg_ws() + WS_HID, arg_ws() + WS_MD8, (const LAS int*)(lds + MOE_TAB), 8 * slot, D / 256, (size_t)256 * DFE, (size_t)D * DFE, G, bx);
                        hv = (S.nM * S.nN) % G;
                        pg8::EpiMoeDown E{(const LAS int*)(lds + MOE_TAB), slot == 0};
                        pg8::gemm_phase<pg8::EpiMoeDown, pg8::MoeOrder<8>, 127 - SC_HID8, 127 - SC_WD8>(lds, DFE / 2, S, E, wv);
                    }
                    if SITE(12) if (st <= 1) {
                        pg8::MoeOrder<8> S; S.init(arg_ws() + WS_XG8, arg_ws() + WS_MGU8, (const LAS int*)(lds + MOE_TAB), 8 * st, 2 * DFE / 256, (size_t)256 * D, (size_t)2 * DFE * D, G, bx);
                        if (st == 1) { S.hv = hv; S.skip = 4; }
                        pg8::EpiSwiGLU8 E{arg_ws() + WS_HID, DFE};
                        pg8::gemm_phase<pg8::EpiSwiGLU8, pg8::MoeOrder<8>, 127 - SC_XN8, 127 - SC_WGU8>(lds, D / 2, S, E, wv);
                    }
                }
                if (st < 2) SEAM(pb + 9 + st);
            }
        }
    }
#undef IN
#undef G
#undef bx
#undef vcu
#undef SEAM
}

extern "C" void kernel_launch(void* const* d_in, const int* in_sizes, int n_in, void* d_out, int out_size, void* d_ws, size_t ws_size, hipStream_t stream) {
    static int grid = 0;
    if (grid == 0) {
        if (n_in != 30 || in_sizes[0] != NTOK * D || out_size != NTOK * D || ws_size < WS_END) { fprintf(stderr, "kernel_launch: unexpected shapes (n_in %d, ws %zu)\n", n_in, ws_size); grid = -1; return; }
        int dev = 0, cus = 0, per_cu = 0;
        if (hipGetDevice(&dev) != hipSuccess || hipDeviceGetAttribute(&cus, hipDeviceAttributeMultiprocessorCount, dev) != hipSuccess) { grid = -1; return; }
        if (hipFuncSetAttribute((const void*)fwd_kernel, hipFuncAttributeMaxDynamicSharedMemorySize, LDS_BYTES) != hipSuccess) { fprintf(stderr, "kernel_launch: hipFuncSetAttribute failed\n"); grid = -1; return; }
        if (hipOccupancyMaxActiveBlocksPerMultiprocessor(&per_cu, (const void*)fwd_kernel, NWAVES * 64, LDS_BYTES) != hipSuccess || per_cu < 1) fprintf(stderr, "kernel_launch: occupancy query reports %d\n", per_cu);
        (void)hipGetLastError();
        grid = cus;
    }
    if (grid < 0) return;
    if (hipMemsetAsync((char*)d_ws + WS_CTL, 0, CTL_ZERO_BYTES, stream) != hipSuccess) return;
    Args a{};
    for (int i = 0; i < 30; ++i) a.in[i] = (const float*)d_in[i];
    a.out = (float*)d_out; a.ws = (unsigned char*)d_ws;
#if MK_MULTI
    for (int p = 0; p < N_PHASES; ++p) for (int r = ((PROBE_MASK >> p) & 1) ? 2 : 1; r > 0; --r) { a.ph_lo = p; a.ph_hi = p + 1; hipLaunchKernelGGL(fwd_kernel, dim3(grid), dim3(NWAVES * 64), LDS_BYTES, stream, a); }
#else
    a.ph_lo = 0; a.ph_hi = N_PHASES;
    hipLaunchKernelGGL(fwd_kernel, dim3(grid), dim3(NWAVES * 64), LDS_BYTES, stream, a);
#endif
}
```

```cpp
#include <hip/hip_runtime.h>
#include <cstdio>
#include <cstdint>

#ifndef MK_MULTI
#define MK_MULTI 0
#endif
#ifndef I8_INPROJ
#define I8_INPROJ 0
#endif
static_assert(!I8_INPROJ, "the prologue no longer builds XQ / RS for an int8 in-proj");
#ifndef I8_OUTPROJ
#define I8_OUTPROJ 0
#endif
#ifndef I8_FFN1
#define I8_FFN1 1
#endif
#ifndef F8_FFN2
#define F8_FFN2 1
#endif
#ifndef PROBE_MASK
#define PROBE_MASK 0
#endif

#define GAS __attribute__((address_space(1)))
#define LAS __attribute__((address_space(3)))
typedef unsigned short bf16;
typedef short bf16x8 __attribute__((ext_vector_type(8)));
typedef float f32x4 __attribute__((ext_vector_type(4)));
typedef float f32x2 __attribute__((ext_vector_type(2)));
typedef float f32x16 __attribute__((ext_vector_type(16)));
typedef unsigned u32x4 __attribute__((ext_vector_type(4)));
typedef unsigned u32x2 __attribute__((ext_vector_type(2)));
typedef GAS unsigned gu32;

constexpr int D = 1024, BATCH = 16, SEQ = 2048, NTOK = BATCH * SEQ, INC = 2304, DFF = 2816, NE = 8, DFE = 3584;
constexpr float EPS = 1e-6f, LOG2E = 1.4426950408889634f;
constexpr int C_Q = 0, C_K = 256, C_V = 512, C_CV = 768, C_CG = 1024, C_GU = 1280, C_GV = 1536, C_LX = 1792, C_LG = 2048;

constexpr size_t MiB = 1u << 20, KiB = 1u << 10;
constexpr size_t WS_CTL = 0, CTL_ZERO_BYTES = 1 * MiB;
constexpr size_t WS_WIN = 1 * MiB;
constexpr size_t WS_WOUT = 10 * MiB;
constexpr size_t WS_WGU = 14 * MiB;
constexpr size_t WS_WD = 25 * MiB;
constexpr size_t WS_GWM = 30 * MiB + 512 * KiB;
constexpr size_t WS_WAT = WS_GWM + 262144;
constexpr size_t WS_WXT = WS_WAT + 65536;
constexpr size_t WS_MGU8 = 31 * MiB;
constexpr size_t WS_MD8 = 87 * MiB;
constexpr size_t WS_XN8 = 115 * MiB;
constexpr size_t WS_XQ = WS_XN8;
constexpr size_t WS_XG8 = 147 * MiB + 256 * KiB;
constexpr size_t WS_YQ = WS_XG8;
constexpr size_t WS_LTOK = 215 * MiB + 256 * KiB;
constexpr size_t WS_LGATE = WS_LTOK + 2 * MiB;
constexpr size_t WS_SS = WS_LGATE + 2 * MiB;
constexpr size_t WS_RS = 512 * KiB;
constexpr size_t WS_RD = 768 * KiB;
constexpr size_t WS_YS = 640 * KiB;
constexpr size_t WS_PROJ = 221 * MiB + 256 * KiB;
constexpr size_t WS_Y = WS_PROJ + 144 * MiB;
constexpr size_t WS_HID = WS_PROJ;
constexpr size_t WS_XB = WS_PROJ + 238 * MiB;
constexpr size_t WS_END = WS_XB + 64 * MiB;
constexpr int SC_XN8 = 4, SC_WGU8 = 4, SC_HID8 = 4, SC_WD8 = 4;

constexpr int CW_TMO = 0;
constexpr int CW_BAR = 4096;
constexpr int CW_MOECNT = 16384;
constexpr int CW_WMAX = 20480;

constexpr int NWAVES = 8;
constexpr int LDS_BYTES = 147456;
constexpr int LDSCTL_OFF = 146944;
constexpr int MOE_TAB = LDSCTL_OFF + 64;

#define RLX_AGENT __ATOMIC_RELAXED, __HIP_MEMORY_SCOPE_AGENT
#define LDS_WAIT() asm volatile("s_waitcnt lgkmcnt(0)" ::: "memory")
#define VM_WAIT() asm volatile("s_waitcnt vmcnt(0)" ::: "memory")
__device__ __forceinline__ int lane_id() { int l; asm volatile("v_mbcnt_lo_u32_b32 %0, -1, 0\n\tv_mbcnt_hi_u32_b32 %0, -1, %0" : "=v"(l)); return l; }
#define OPAQUE_U(x) asm volatile("" : "+s"(x))
#define OPAQUE_TID() int wave_ = wv; asm volatile("" : "+s"(wave_)); int tid = wave_ * 64 + lane_id(); asm volatile("" : "+v"(tid)); const int lane = tid & 63, wave = wave_; (void)lane; (void)wave

__device__ __forceinline__ float bf_lo(unsigned w) { return __uint_as_float(w << 16); }
__device__ __forceinline__ float bf_hi(unsigned w) { return __uint_as_float(w & 0xffff0000u); }
typedef __bf16 bf16x2_t __attribute__((ext_vector_type(2)));
__device__ __forceinline__ unsigned pk2(float lo, float hi) { f32x2 v = {lo, hi}; bf16x2_t b = __builtin_convertvector(v, bf16x2_t); return __builtin_bit_cast(unsigned, b); }
__device__ __forceinline__ unsigned pk4_fp8(float a, float b, float c, float d) {
    a = __builtin_amdgcn_fmed3f(a, -448.f, 448.f); b = __builtin_amdgcn_fmed3f(b, -448.f, 448.f); c = __builtin_amdgcn_fmed3f(c, -448.f, 448.f); d = __builtin_amdgcn_fmed3f(d, -448.f, 448.f);
    int v = 0; v = __builtin_amdgcn_cvt_pk_fp8_f32(a, b, v, false); v = __builtin_amdgcn_cvt_pk_fp8_f32(c, d, v, true); return (unsigned)v; }
template <int CTRL> __device__ __forceinline__ float dppf(float v) { return __int_as_float(__builtin_amdgcn_update_dpp(0, __float_as_int(v), CTRL, 0xf, 0xf, true)); }
template <int M> __device__ __forceinline__ float swz_xor(float v) { static_assert(M == 1 || M == 2 || M == 4 || M == 8, "M"); return dppf<M == 1 ? 0xB1 : M == 2 ? 0x4E : M == 4 ? 0x141 : 0x128>(v); }
__device__ __forceinline__ void rows16(float v, float& a, float& b) { auto r = __builtin_amdgcn_permlane16_swap(__float_as_uint(v), __float_as_uint(v), false, false); a = __uint_as_float(r[0]); b = __uint_as_float(r[1]); }
__device__ __forceinline__ float sum_rows16(float v) { float a, b; rows16(v, a, b); return a + b; }
__device__ __forceinline__ void halves(float v, float& lo, float& hi) { auto r = __builtin_amdgcn_permlane32_swap(__float_as_uint(v), __float_as_uint(v), false, false); lo = __uint_as_float(r[0]); hi = __uint_as_float(r[1]); }
__device__ __forceinline__ float sum_halves(float v) { float lo, hi; halves(v, lo, hi); return lo + hi; }
__device__ __forceinline__ unsigned pk4_i8(float a, float b, float c, float d) {
    const int q0 = __float2int_rn(a), q1 = __float2int_rn(b), q2 = __float2int_rn(c), q3 = __float2int_rn(d);
    return (unsigned)(q0 & 255) | ((unsigned)(q1 & 255) << 8) | ((unsigned)(q2 & 255) << 16) | ((unsigned)q3 << 24); }
__device__ __forceinline__ float wave_max(float v);
__device__ __forceinline__ float wave_sum(float v) {
    v += swz_xor<1>(v); v += swz_xor<2>(v); v += swz_xor<4>(v); v += swz_xor<8>(v); v = sum_rows16(v);
    return sum_halves(v);
}
__device__ __forceinline__ float one_minus_exp(float y) {
    const float ser = -y * (1.f + y * (0.5f + y * (0.16666667f + y * (0.041666668f + y * (0.008333334f + y * 0.0013888889f)))));
    const float dir = 1.f - __builtin_amdgcn_exp2f(y * LOG2E);
    return y > -0.25f ? ser : dir;
}
__device__ __forceinline__ float fast_sigmoid(float x) { return __builtin_amdgcn_rcpf(1.0f + __builtin_amdgcn_exp2f(-x * LOG2E)); }
__device__ __forceinline__ float gelu_tanh(float x) { const float u = x + 0.044715f * x * x * x; return x * __builtin_amdgcn_rcpf(1.0f + __builtin_amdgcn_exp2f(-2.0f * 0.7978845608f * LOG2E * u)); }

__device__ __forceinline__ float wave_max(float v) {
    v = fmaxf(v, swz_xor<1>(v)); v = fmaxf(v, swz_xor<2>(v)); v = fmaxf(v, swz_xor<4>(v)); v = fmaxf(v, swz_xor<8>(v)); { float a, b; rows16(v, a, b); v = fmaxf(a, b); }
    float lo, hi; halves(v, lo, hi); return fmaxf(lo, hi);
}
struct Args { const float* in[30]; float* out; unsigned char* ws; int ph_lo, ph_hi; };
typedef __attribute__((address_space(4))) const Args* KArgsPtr;
__device__ __forceinline__ KArgsPtr kargs() { KArgsPtr p = (KArgsPtr)__builtin_amdgcn_kernarg_segment_ptr(); asm volatile("" : "+s"(p)); return p; }
__device__ __forceinline__ int opq_s(int x) { asm volatile("" : "+s"(x)); return x; }
__device__ __forceinline__ const float* arg_in(int i) { return kargs()->in[i]; }
__device__ __forceinline__ float* arg_out() { return kargs()->out; }
__device__ __forceinline__ unsigned char* arg_ws() { return kargs()->ws; }

namespace pg8 {
constexpr int BM = 256, BK = 64, HALF = 128, HTB = HALF * BK * 2, STAGE_BYTES = 8 * HTB, NXCD = 8, WGM = 8;
__host__ __device__ __forceinline__ int lds_byte(int r, int c) { const int st = (r >> 4) * 2 + (c >> 5), rr = r & 15, cc = c & 31, ob = rr * 64 + cc * 2; return st * 1024 + (ob ^ (((ob >> 9) & 1) << 5)); }
__host__ __device__ __forceinline__ void stage_rc(int b, int& R, int& C) { const int st = b / 1024, sb = b % 1024, swz = sb ^ (((sb >> 9) & 1) << 5); R = (st >> 1) * 16 + swz / 64; C = (st & 1) * 32 + (swz % 64) / 2; }
__host__ __device__ __forceinline__ int perm32(int rho) { const int n = rho >> 4, i = rho & 15; return 8 * (i >> 2) + 4 * n + (i & 3); }

struct Unit { int pm, pn, e, mt, se; };

__device__ __forceinline__ bool static_unit_L(long L, int nM, int nN, int& pm, int& pn) {
    const int nwg = nM * nN; if (L >= nwg) return false;
    int wgid = (int)L; { const int q = nwg / NXCD, r = nwg % NXCD, xcd = wgid % NXCD, off = wgid / NXCD; wgid = (xcd < r ? xcd * (q + 1) : r * (q + 1) + (xcd - r) * q) + off; }
    const int nig = WGM * nN, gid = wgid / nig, fm = gid * WGM, gsz = (nM - fm) < WGM ? (nM - fm) : WGM;
    pm = fm + ((wgid % nig) % gsz); pn = (wgid % nig) / gsz; return true;
}
__device__ __forceinline__ bool static_unit(int i, int G, int c, int nM, int nN, int& pm, int& pn) { return static_unit_L((long)i * G + c, nM, nN, pm, pn); }
struct DenseOrder {
    static constexpr bool GATHER = false;
    const char* A; const char* B; int nM, nN, G, c; unsigned tstep;
    __device__ __forceinline__ void init(const void* A_, const void* B_, int M, int N, int K, int G_, int c_) { A = (const char*)A_; B = (const char*)B_; nM = M / BM; nN = N / BM; G = G_; c = c_; tstep = (unsigned)BM * K * 2; }
    __device__ __forceinline__ bool next(int i, Unit& u) const { u.e = 0; u.mt = 0; u.se = 0; return static_unit(i, G, c, nM, nN, u.pm, u.pn); }
    __device__ __forceinline__ unsigned aoff(const Unit& u) const { return (unsigned)u.pm * (unsigned)tstep; }
    __device__ __forceinline__ unsigned boff(const Unit& u) const { return (unsigned)u.pn * (unsigned)tstep; }
    __device__ __forceinline__ void rows(const Unit&, int, int, unsigned (&)[2][2]) const {}
};
template <int NSE> struct MoeOrder {
    static constexpr bool GATHER = false;
    const char* A; const char* B; const LAS int* tab; int se0, pm0, nM, nN, G, c; unsigned tstep, bstride;
    int hv = 0, skip = 0;
    __device__ __forceinline__ void init(const void* A_, const void* B_, const LAS int* tab_, int se0_, int nN_, unsigned tstep_, unsigned bstride_, int G_, int c_) {
        A = (const char*)A_; B = (const char*)B_; tab = tab_; se0 = se0_; pm0 = __builtin_amdgcn_readfirstlane(tab_[16 + se0_]); nM = __builtin_amdgcn_readfirstlane(tab_[16 + se0_ + NSE]) - pm0;
        nN = nN_; tstep = tstep_; bstride = bstride_; G = G_; c = c_; }
    __device__ __forceinline__ bool next(int i, Unit& u) const {
        const int Gl = G - hv; long L;
        if (c >= hv) L = i < skip ? (long)i * Gl + (c - hv) : (long)skip * Gl + (long)(i - skip) * G + c; else L = (long)skip * Gl + (long)i * G + c;
        int pl; if (!static_unit_L(L, nM, nN, pl, u.pn)) return false;
        const int pm = pm0 + pl; int se = se0;
#pragma unroll
        for (int j = 1; j < NSE; ++j) se += (pm >= tab[16 + se0 + j]) ? 1 : 0;
        se = __builtin_amdgcn_readfirstlane(se);
        u.pm = pm; u.se = se; u.e = se & 7; u.mt = __builtin_amdgcn_readfirstlane(pm - tab[16 + se]); return true;
    }
    __device__ __forceinline__ unsigned aoff(const Unit& u) const { return (unsigned)u.pm * (unsigned)tstep; }
    __device__ __forceinline__ unsigned boff(const Unit& u) const { return (unsigned)u.e * (unsigned)bstride + (unsigned)u.pn * (unsigned)tstep; }
    __device__ __forceinline__ void rows(const Unit&, int, int, unsigned (&)[2][2]) const {}
};

struct EpiBf16 {
    static constexpr bool PERM = true; static constexpr int NPRE = 8;
    bf16* O; int ldc; const float* rs; float wsc;
    __device__ __forceinline__ void preload(float (&pre)[8], const Unit& u, int wr, int fr) const {
#pragma unroll
        for (int i = 0; i < 8; ++i) pre[i] = rs[u.pm * BM + wr * 64 + fr + (i >> 2) * HALF + (i & 3) * 16];
    }
    __device__ __forceinline__ void operator()(const f32x4 (&acc)[2][2][4][2], const Unit& u, int wr, int wc, int fr, int fq, const float (&rsv)[8]) const {
        const int row0 = u.pm * BM + wr * 64 + fr, col0 = u.pn * BM + wc * 32 + 8 * fq;
#pragma unroll
        for (int ai = 0; ai < 2; ++ai)
#pragma unroll
            for (int m = 0; m < 4; ++m) { const int r = row0 + ai * HALF + m * 16; bf16* rowp = O + (size_t)r * ldc + col0; const float rs = rsv[ai * 4 + m] * wsc;
#pragma unroll
                for (int bj = 0; bj < 2; ++bj) { const f32x4 v0 = acc[ai][bj][m][0] * rs, v1 = acc[ai][bj][m][1] * rs;
                    u32x4 w; w.x = pk2(v0[0], v0[1]); w.y = pk2(v0[2], v0[3]); w.z = pk2(v1[0], v1[1]); w.w = pk2(v1[2], v1[3]);
                    *(u32x4*)(rowp + bj * HALF) = w; } }
    }
};
template <bool RF32, bool SCALED, bool SSOUT = false> struct EpiResB {
    static constexpr int NPRE = SCALED ? 8 : 0; static constexpr bool PERM = true;
    const float* R; bf16* XB; const float* ys; float wsc; float* SS;
    __device__ __forceinline__ void preload(float (&pre)[8], const Unit& u, int wr, int fr) const {
#pragma unroll
        for (int i = 0; i < 8; ++i) pre[i] = ys[u.pm * BM + wr * 64 + fr + (i >> 2) * HALF + (i & 3) * 16];
    }
    __device__ __forceinline__ void operator()(const f32x4 (&acc)[2][2][4][2], const Unit& u, int wr, int wc, int fr, int fq, const float (&pre)[8]) const { run(acc, u, wr, wc, fr, fq, pre); }
    __device__ __forceinline__ void operator()(const f32x4 (&acc)[2][2][4][2], const Unit& u, int wr, int wc, int fr, int fq) const { const float one[8] = {1.f, 1.f, 1.f, 1.f, 1.f, 1.f, 1.f, 1.f}; run(acc, u, wr, wc, fr, fq, one); }
    __device__ __forceinline__ void run(const f32x4 (&acc)[2][2][4][2], const Unit& u, int wr, int wc, int fr, int fq, const float (&pre)[8]) const {
        const int row0 = u.pm * BM + wr * 64 + fr, col0 = u.pn * BM + wc * 32 + 8 * fq;
#pragma unroll
        for (int aj = 0; aj < 4; ++aj) { const int ai = aj >> 1, m0 = 2 * (aj & 1); constexpr int MG = 2;
            f32x4 xr[4][2][2]; u32x4 xb_[4][2];
#pragma unroll
            for (int m = m0; m < m0 + MG; ++m) { const size_t ro = (size_t)(row0 + ai * HALF + m * 16) * D + col0;
#pragma unroll
                for (int bj = 0; bj < 2; ++bj) {
                    if constexpr (RF32) { xr[m][bj][0] = *(const f32x4*)(R + ro + bj * HALF); xr[m][bj][1] = *(const f32x4*)(R + ro + bj * HALF + 4); }
                    else xb_[m][bj] = *(const u32x4*)(XB + ro + bj * HALF); } }
            asm volatile("" ::: "memory");
#pragma unroll
            for (int m = m0; m < m0 + MG; ++m) { const int r = row0 + ai * HALF + m * 16; const size_t ro = (size_t)r * D + col0; const float f = SCALED ? pre[ai * 4 + m] * wsc : 1.f;
                f32x4 xv[2][2];
#pragma unroll
                for (int bj = 0; bj < 2; ++bj) {
                    if constexpr (RF32) { xv[bj][0] = xr[m][bj][0]; xv[bj][1] = xr[m][bj][1]; }
                    else { const u32x4 b = xb_[m][bj]; xv[bj][0] = (f32x4){bf_lo(b.x), bf_hi(b.x), bf_lo(b.y), bf_hi(b.y)}; xv[bj][1] = (f32x4){bf_lo(b.z), bf_hi(b.z), bf_lo(b.w), bf_hi(b.w)}; } }
                float sq = 0.f;
#pragma unroll
                for (int bj = 0; bj < 2; ++bj) { const f32x4 x0 = xv[bj][0] + acc[ai][bj][m][0] * f, x1 = xv[bj][1] + acc[ai][bj][m][1] * f;
                    if constexpr (SSOUT) sq += ((x0.x * x0.x + x0.y * x0.y) + (x0.z * x0.z + x0.w * x0.w)) + ((x1.x * x1.x + x1.y * x1.y) + (x1.z * x1.z + x1.w * x1.w));
                    u32x4 o; o.x = pk2(x0.x, x0.y); o.y = pk2(x0.z, x0.w); o.z = pk2(x1.x, x1.y); o.w = pk2(x1.z, x1.w); *(u32x4*)(XB + ro + bj * HALF) = o; }
                if constexpr (SSOUT) { sq = sum_rows16(sq); sq = sum_halves(sq); if (fq == 0) SS[(size_t)r * 16 + 4 * u.pn + wc] = sq; } }
        }
    }
};
__device__ __forceinline__ float silu_mul(float g, float u) { return g * __builtin_amdgcn_rcpf(1.0f + __builtin_amdgcn_exp2f(-g * LOG2E)) * u; }
struct EpiSwiGLU {
    static constexpr bool PERM = true; static constexpr int NPRE = 8;
    bf16* H; int ldh; const float* rs; float wsc;
    __device__ __forceinline__ void preload(float (&pre)[8], const Unit& u, int wr, int fr) const {
#pragma unroll
        for (int i = 0; i < 8; ++i) pre[i] = rs[u.pm * BM + wr * 64 + fr + (i >> 2) * HALF + (i & 3) * 16];
    }
    __device__ __forceinline__ void operator()(const f32x4 (&acc)[2][2][4][2], const Unit& u, int wr, int wc, int fr, int fq, const float (&rsv)[8]) const {
        const int row0 = u.pm * BM + wr * 64 + fr, col0 = u.pn * HALF + wc * 32 + 8 * fq;
#pragma unroll
        for (int ai = 0; ai < 2; ++ai)
#pragma unroll
            for (int m = 0; m < 4; ++m) { const int r = row0 + ai * HALF + m * 16; bf16* rowp = H + (size_t)r * ldh + col0; const float rs = rsv[ai * 4 + m] * wsc;
                const f32x4 g0 = acc[ai][0][m][0] * rs, g1 = acc[ai][0][m][1] * rs, u0 = acc[ai][1][m][0] * rs, u1 = acc[ai][1][m][1] * rs;
                u32x4 w; w.x = pk2(silu_mul(g0[0], u0[0]), silu_mul(g0[1], u0[1])); w.y = pk2(silu_mul(g0[2], u0[2]), silu_mul(g0[3], u0[3]));
                w.z = pk2(silu_mul(g1[0], u1[0]), silu_mul(g1[1], u1[1])); w.w = pk2(silu_mul(g1[2], u1[2]), silu_mul(g1[3], u1[3]));
                *(u32x4*)rowp = w; }
    }
};
struct EpiSwiGLUF8 {
    static constexpr bool PERM = true; static constexpr int NPRE = 8;
    unsigned char* H; int ldh; const float* rs; float wsc;
    __device__ __forceinline__ void preload(float (&pre)[8], const Unit& u, int wr, int fr) const {
#pragma unroll
        for (int i = 0; i < 8; ++i) pre[i] = rs[u.pm * BM + wr * 64 + fr + (i >> 2) * HALF + (i & 3) * 16];
    }
    __device__ __forceinline__ void operator()(const f32x4 (&acc)[2][2][4][2], const Unit& u, int wr, int wc, int fr, int fq, const float (&rsv)[8]) const {
        const int row0 = u.pm * BM + wr * 64 + fr, col0 = u.pn * HALF + wc * 32 + 8 * fq; const float sc = (float)(1 << SC_HID8);
#pragma unroll
        for (int ai = 0; ai < 2; ++ai)
#pragma unroll
            for (int m = 0; m < 4; ++m) { unsigned char* rowp = H + (size_t)(row0 + ai * HALF + m * 16) * ldh + col0; const float f = rsv[ai * 4 + m] * wsc;
                const f32x4 g0 = acc[ai][0][m][0] * f, g1 = acc[ai][0][m][1] * f, u0 = acc[ai][1][m][0] * f, u1 = acc[ai][1][m][1] * f;
                u32x2 w; w.x = pk4_fp8(sc * silu_mul(g0[0], u0[0]), sc * silu_mul(g0[1], u0[1]), sc * silu_mul(g0[2], u0[2]), sc * silu_mul(g0[3], u0[3]));
                w.y = pk4_fp8(sc * silu_mul(g1[0], u1[0]), sc * silu_mul(g1[1], u1[1]), sc * silu_mul(g1[2], u1[2]), sc * silu_mul(g1[3], u1[3]));
                *(u32x2*)rowp = w; }
    }
};
struct EpiSwiGLU8 {
    static constexpr bool PERM = false; static constexpr int NPRE = 0;
    unsigned char* H; int ldh;
    __device__ __forceinline__ void operator()(const f32x4 (&acc)[2][2][4][2], const Unit& u, int wr, int wc, int fr, int fq) const {
        const int row0 = u.pm * BM + wr * 64 + fr, col0 = u.pn * HALF + wc * 32 + 4 * fq; const float sc = (float)(1 << SC_HID8);
#pragma unroll
        for (int ai = 0; ai < 2; ++ai)
#pragma unroll
            for (int m = 0; m < 4; ++m) { unsigned char* rowp = H + (size_t)(row0 + ai * HALF + m * 16) * ldh + col0;
#pragma unroll
                for (int n = 0; n < 2; ++n) { const f32x4 g = acc[ai][0][m][n], up = acc[ai][1][m][n];
                    *(unsigned*)(rowp + 16 * n) = pk4_fp8(sc * silu_mul(g[0], up[0]), sc * silu_mul(g[1], up[1]), sc * silu_mul(g[2], up[2]), sc * silu_mul(g[3], up[3])); } }
    }
};
struct EpiMoeDown {
    static constexpr bool PERM = false; static constexpr int NPRE = 0;
    const LAS int* tab; int first;
    __device__ __forceinline__ void operator()(const f32x4 (&acc)[2][2][4][2], const Unit& u, int wr, int wc, int fr, int fq) const {
        float* C = arg_out(); const int cnt = tab[u.se]; const int* lt = (const int*)(arg_ws() + WS_LTOK) + (size_t)u.se * NTOK; const float* lg = (const float*)(arg_ws() + WS_LGATE) + (size_t)u.se * NTOK;
        const int p0 = u.mt * 256 + wr * 64 + fr, col0 = u.pn * BM + wc * 32 + 4 * fq;
#pragma unroll
        for (int ai = 0; ai < 2; ++ai)
#pragma unroll
            for (int m = 0; m < 4; ++m) { const int p = p0 + ai * HALF + m * 16;
                if (p < cnt) { const int tok = lt[p]; const float g = lg[p]; float* rowp = C + (size_t)tok * D + col0; bf16* xrow = (bf16*)(arg_ws() + WS_XB) + (size_t)tok * D + col0;
                    f32x4 rv[2][2];
#pragma unroll
                    for (int bj = 0; bj < 2; ++bj)
#pragma unroll
                        for (int n = 0; n < 2; ++n) { const u32x2 b = *(const u32x2*)(xrow + bj * HALF + n * 16); rv[bj][n] = (f32x4){bf_lo(b.x), bf_hi(b.x), bf_lo(b.y), bf_hi(b.y)}; }
#pragma unroll
                    for (int bj = 0; bj < 2; ++bj)
#pragma unroll
                        for (int n = 0; n < 2; ++n) { const f32x4 x = rv[bj][n] + g * acc[ai][bj][m][n];
                            if (first) { u32x2 o; o.x = pk2(x.x, x.y); o.y = pk2(x.z, x.w); *(u32x2*)(xrow + bj * HALF + n * 16) = o; }
                            else *(f32x4*)(rowp + bj * HALF + n * 16) = x; } } }
    }
};

typedef int v8i_t __attribute__((ext_vector_type(8)));
typedef int v4i_t __attribute__((ext_vector_type(4)));
__device__ __forceinline__ v8i_t cat8(bf16x8 a, bf16x8 b) { return __builtin_shufflevector(__builtin_bit_cast(v4i_t, a), __builtin_bit_cast(v4i_t, b), 0, 1, 2, 3, 4, 5, 6, 7); }
template <class Epi, class Sched, int SA = -1, int SB = -1, bool I8 = false>
__device__ __forceinline__ void gemm_phase(LAS unsigned char* lds, const int K, const Sched& S, const Epi& E, const int wv) {
    int wid_ = wv; asm volatile("" : "+s"(wid_));
    int tid_ = wid_ * 64 + lane_id(); asm volatile("" : "+v"(tid_));
    const int tid = tid_, wid = wid_, lane = tid & 63, wr = wid >> 2, wc = wid & 3, fr = lane & 15, fq = lane >> 4;
    const int nt = K / BK;
    unsigned voffB[2];
    unsigned offAc[2][2];
    LAS u32x4* stash = (LAS u32x4*)(lds + STAGE_BYTES) + tid;
    const unsigned kstep = (unsigned)(BK * 2);
    const unsigned hstep = (unsigned)HALF * (unsigned)K * 2u;
#pragma unroll
    for (int i = 0; i < 2; ++i) { int R, C; stage_rc(tid * 16 + i * 8192, R, C); const int Rb = Epi::PERM ? ((R & ~31) + perm32(R & 31)) : R;
        voffB[i] = (unsigned)(Rb * K + C) * 2u;
        offAc[0][i] = (unsigned)(R * K + C) * 2u; offAc[1][i] = offAc[0][i] + hstep; }
    const __amdgpu_buffer_rsrc_t rA = __builtin_amdgcn_make_buffer_rsrc((void*)S.A, 0, 0x7ffffff0, 0x00020000);
    const __amdgpu_buffer_rsrc_t rB = __builtin_amdgcn_make_buffer_rsrc((void*)S.B, 0, 0x7ffffff0, 0x00020000);
    const unsigned ldsw = (unsigned)wid * 1024u;
    const int aoff = lds_byte(wr * 64 + fr, fq * 8), boff = lds_byte(wc * 32 + fr, fq * 8);
#define PG8_SA(b, h) (((b) * 2 + (h)) * HTB)
#define PG8_SB(b, h) ((4 + (b) * 2 + (h)) * HTB)
#define PG8_STAGE_R(bufoff, rs, soff, voff) do { _Pragma("unroll") for (int _i = 0; _i < 2; ++_i) \
        __builtin_amdgcn_raw_ptr_buffer_load_lds(rs, (LAS unsigned*)(lds + (bufoff) + ldsw + _i * 8192), 16, (voff)[_i], (soff), 0, 0); } while (0)
#define PG8_STAGE_A(bufoff, soff, voff) PG8_STAGE_R(bufoff, rA, soff, voff)
#define PG8_STAGE_A1(bufoff, soff) do { if constexpr (Sched::GATHER) PG8_STAGE_R(bufoff, rA, soff, offAc[1]); else PG8_STAGE_R(bufoff, rA, (soff) + hstep, offAc[0]); } while (0)
#define PG8_STAGE_B(bufoff, soff, voff) PG8_STAGE_R(bufoff, rB, soff, voff)
#define PG8_LDA(dst, b, h) do { _Pragma("unroll") for (int m = 0; m < 4; ++m) _Pragma("unroll") for (int k = 0; k < 2; ++k) dst[m][k] = *(const LAS bf16x8*)(lds + PG8_SA(b, h) + aoff + m * 2048 + k * 1024); } while (0)
#define PG8_LDB(dst, b, h) do { _Pragma("unroll") for (int n = 0; n < 2; ++n) _Pragma("unroll") for (int k = 0; k < 2; ++k) dst[n][k] = *(const LAS bf16x8*)(lds + PG8_SB(b, h) + boff + n * 2048 + k * 1024); } while (0)
#define PG8_MMA(ai, bj, At, Bt) do { __builtin_amdgcn_s_setprio(1); _Pragma("unroll") for (int m = 0; m < 4; ++m) _Pragma("unroll") for (int n = 0; n < 2; ++n) { \
        if constexpr (SA >= 0) acc[ai][bj][m][n] = __builtin_amdgcn_mfma_scale_f32_16x16x128_f8f6f4(cat8(Bt[n][0], Bt[n][1]), cat8(At[m][0], At[m][1]), acc[ai][bj][m][n], 0, 0, 0, scl_b, 0, scl_a); \
        else if constexpr (I8) { _Pragma("unroll") for (int k = 0; k < 2; ++k) acc[ai][bj][m][n] = __builtin_bit_cast(f32x4, __builtin_amdgcn_mfma_i32_16x16x64_i8(__builtin_bit_cast(v4i_t, Bt[n][k]), __builtin_bit_cast(v4i_t, At[m][k]), __builtin_bit_cast(v4i_t, acc[ai][bj][m][n]), 0, 0, 0)); } \
        else { _Pragma("unroll") for (int k = 0; k < 2; ++k) acc[ai][bj][m][n] = __builtin_amdgcn_mfma_f32_16x16x32_bf16(Bt[n][k], At[m][k], acc[ai][bj][m][n], 0, 0, 0); } } \
        __builtin_amdgcn_s_setprio(0); } while (0)
#define PG8_WAIT_V(n) asm volatile("s_waitcnt vmcnt(" #n ")" ::: "memory")
#define PG8_WAIT_L(n) asm volatile("s_waitcnt lgkmcnt(" #n ")" ::: "memory")
#define PG8_BAR __builtin_amdgcn_s_barrier()
#define PG8_SCHED __builtin_amdgcn_sched_barrier(0)
    int scl_a = SA * 0x01010101; asm volatile("" : "+v"(scl_a));
    const int scl_b = (SA == SB) ? scl_a : SB * 0x01010101;
    Unit cur, nxt; int ui = 0;
    if (!S.next(0, cur)) return;
    f32x4 acc[2][2][4][2];
#pragma unroll
    for (int a = 0; a < 2; ++a)
#pragma unroll
        for (int b = 0; b < 2; ++b)
#pragma unroll
            for (int m = 0; m < 4; ++m)
#pragma unroll
                for (int n = 0; n < 2; ++n) acc[a][b][m][n] = (f32x4){0.f, 0.f, 0.f, 0.f};
    bf16x8 At[4][2], B0[2][2], B1[2][2];
    unsigned cA = S.aoff(cur), cB = S.boff(cur);
    if constexpr (Sched::GATHER) S.rows(cur, tid, K, offAc);
    PG8_STAGE_B(PG8_SB(0, 0), cB, voffB); PG8_STAGE_B(PG8_SB(0, 1), cB + hstep, voffB); PG8_STAGE_A(PG8_SA(0, 0), cA, offAc[0]); PG8_STAGE_A1(PG8_SA(0, 1), cA);
    if (wr == 1) PG8_BAR;
    PG8_WAIT_V(2); PG8_BAR;
    PG8_STAGE_B(PG8_SB(1, 0), cB + kstep, voffB); PG8_STAGE_A(PG8_SA(1, 0), cA + kstep, offAc[0]); PG8_STAGE_B(PG8_SB(1, 1), cB + hstep + kstep, voffB);
    PG8_WAIT_V(6); PG8_BAR;
    for (;;) {
        const bool has_next = S.next(ui + 1, nxt);
        const unsigned nA = has_next ? S.aoff(nxt) : cA, nB = has_next ? S.boff(nxt) : cB;
        float epre[Epi::NPRE ? Epi::NPRE : 1];
        if constexpr (Epi::NPRE > 0) { int l1 = lane_id(); asm volatile("" : "+v"(l1)); E.preload(epre, cur, wr, l1 & 15); }
        if constexpr (Sched::GATHER) { unsigned offAn[2][2];
            if (has_next) S.rows(nxt, tid, K, offAn);
            else {
#pragma unroll
                for (int h = 0; h < 2; ++h) { offAn[h][0] = offAc[h][0]; offAn[h][1] = offAc[h][1]; } }
            *stash = (u32x4){offAn[0][0], offAn[0][1], offAn[1][0], offAn[1][1]}; }
#pragma clang loop unroll(disable)
        for (int t = 0; t < nt; t += 2) {
            const bool last = (t == nt - 2);
            const unsigned a1 = cA + (unsigned)(t + 1) * kstep;
            const unsigned a2 = last ? nA : cA + (unsigned)(t + 2) * kstep, b2 = last ? nB : cB + (unsigned)(t + 2) * kstep;
            const unsigned a3 = a2 + kstep, b3 = b2 + kstep;
            PG8_LDB(B0, 0, 0); PG8_LDB(B1, 0, 1); PG8_SCHED; PG8_LDA(At, 0, 0); PG8_STAGE_A1(PG8_SA(1, 1), a1);
            if constexpr (Sched::GATHER) {
                const unsigned lm = last ? 0xffffffffu : 0u; const u32x4 nx = *stash;
                offAc[0][0] = (offAc[0][0] & ~lm) | (nx.x & lm); offAc[0][1] = (offAc[0][1] & ~lm) | (nx.y & lm); offAc[1][0] = (offAc[1][0] & ~lm) | (nx.z & lm); offAc[1][1] = (offAc[1][1] & ~lm) | (nx.w & lm); }
            PG8_WAIT_V(8); PG8_WAIT_L(0); PG8_BAR; PG8_MMA(0, 0, At, B0); PG8_MMA(0, 1, At, B1); PG8_BAR; PG8_SCHED;
            PG8_LDA(At, 0, 1); PG8_STAGE_B(PG8_SB(0, 0), b2, voffB); PG8_STAGE_B(PG8_SB(0, 1), b2 + hstep, voffB); PG8_STAGE_A(PG8_SA(0, 0), a2, offAc[0]);
            PG8_WAIT_V(8); PG8_WAIT_L(0); PG8_BAR; PG8_MMA(1, 0, At, B0); PG8_MMA(1, 1, At, B1); PG8_BAR; PG8_SCHED;
            PG8_LDB(B0, 1, 0); PG8_LDB(B1, 1, 1); PG8_SCHED; PG8_LDA(At, 1, 0); PG8_STAGE_A1(PG8_SA(0, 1), a2);
            PG8_WAIT_V(8); PG8_WAIT_L(0); PG8_BAR; PG8_MMA(0, 0, At, B0); PG8_MMA(0, 1, At, B1); PG8_BAR; PG8_SCHED;
            PG8_LDA(At, 1, 1); PG8_STAGE_B(PG8_SB(1, 0), b3, voffB); PG8_STAGE_B(PG8_SB(1, 1), b3 + hstep, voffB); PG8_STAGE_A(PG8_SA(1, 0), a3, offAc[0]);
            PG8_WAIT_V(8); PG8_WAIT_L(0); PG8_BAR; PG8_MMA(1, 0, At, B0); PG8_MMA(1, 1, At, B1); PG8_BAR; PG8_SCHED;
        }
        if (wr == 0) PG8_BAR;
        PG8_SCHED;
        if constexpr (I8) {
#pragma unroll
            for (int a = 0; a < 2; ++a)
#pragma unroll
                for (int b = 0; b < 2; ++b)
#pragma unroll
                    for (int m = 0; m < 4; ++m)
#pragma unroll
                        for (int n = 0; n < 2; ++n) { const v4i_t q = __builtin_bit_cast(v4i_t, acc[a][b][m][n]); acc[a][b][m][n] = (f32x4){(float)q.x, (float)q.y, (float)q.z, (float)q.w}; } }
        { int l2 = lane_id(); asm volatile("" : "+v"(l2)); if constexpr (Epi::NPRE > 0) E(acc, cur, wr, wc, l2 & 15, l2 >> 4, epre); else E(acc, cur, wr, wc, l2 & 15, l2 >> 4); }
        PG8_SCHED;
        if (!has_next) break;
#pragma unroll
        for (int a = 0; a < 2; ++a)
#pragma unroll
            for (int b = 0; b < 2; ++b)
#pragma unroll
                for (int m = 0; m < 4; ++m)
#pragma unroll
                    for (int n = 0; n < 2; ++n) acc[a][b][m][n] = (f32x4){0.f, 0.f, 0.f, 0.f};
        PG8_SCHED;
        cur = nxt; cA = nA; cB = nB; ++ui;
        if (wr == 1) PG8_BAR;
    }
    PG8_WAIT_V(0);
    PG8_BAR;
#undef PG8_SA
#undef PG8_SB
#undef PG8_STAGE_R
#undef PG8_STAGE_A
#undef PG8_STAGE_A1
#undef PG8_STAGE_B
#undef PG8_LDA
#undef PG8_LDB
#undef PG8_MMA
#undef PG8_WAIT_V
#undef PG8_WAIT_L
#undef PG8_BAR
#undef PG8_SCHED
}
}

#define XB_TMO      128
#define XB_XCNT(j)  (256  + 64 * (j))
#define XB_XSUB(j)  (1280 + 64 * (j))
#define XB_XGEN(j)  (2304 + 64 * (j))
#define XB_TOP      3328
#define XB_TOPGEN   3392
#define XCD_BAR_WORDS 3456
#define XB_SPIN_CAP (1u << 18)
__device__ __forceinline__ unsigned long long xb_z() { unsigned long long z; asm volatile("v_mov_b64 %0, 0" : "=v"(z)); return z; }
__device__ __forceinline__ unsigned xb_ld(unsigned* p)              { return __hip_atomic_load(p + xb_z(), __ATOMIC_RELAXED, __HIP_MEMORY_SCOPE_AGENT); }
__device__ __forceinline__ unsigned xb_add(unsigned* p, unsigned v) { return __hip_atomic_fetch_add(p + xb_z(), v, __ATOMIC_RELAXED, __HIP_MEMORY_SCOPE_AGENT); }
__device__ __forceinline__ unsigned xb_xcc_id() { return (unsigned)__builtin_amdgcn_s_getreg((3 << 11) | 20) & 0xFu; }
#define XB_SPIN(cond, bar) do { unsigned _sp = 0; while (cond) { __builtin_amdgcn_s_sleep(1); \
    if ((++_sp & 255u) == 0u) { if (xb_ld(&(bar)[XB_TMO])) break; if (_sp > XB_SPIN_CAP) { (void)xb_add(&(bar)[XB_TMO], 1u); break; } } } } while (0)
struct XcdBarrier { unsigned* bar; unsigned x; volatile LAS unsigned* st; };
__device__ __forceinline__ XcdBarrier xcd_barrier_post(unsigned* bar, volatile LAS unsigned* st, bool t0) {
    XcdBarrier b; b.bar = bar; b.x = xb_xcc_id(); b.st = st;
    if (t0) (void)xb_add(&bar[XB_XCNT(b.x)], 1u);
    return b;
}
__device__ __forceinline__ void xcd_barrier_complete(unsigned* bar, unsigned x, unsigned& nloc, unsigned& nx) {
    const unsigned G = gridDim.x * gridDim.y * gridDim.z;
    unsigned sum, cnt, mine, sp = 0u;
    for (;;) {
        sum = 0u; cnt = 0u; mine = 0u;
#pragma unroll
        for (unsigned j = 0; j < 16; ++j) { const unsigned c = xb_ld(&bar[XB_XCNT(j)]); sum += c; cnt += (c > 0u) ? 1u : 0u; mine = (j == x) ? c : mine; }
        if (sum == G) break;
        __builtin_amdgcn_s_sleep(1);
        if ((++sp & 255u) == 0u) { if (xb_ld(&bar[XB_TMO])) break; if (sp > XB_SPIN_CAP) { (void)xb_add(&bar[XB_TMO], 1u); break; } }
    }
    nloc = mine > 0u ? mine : 1u; nx = cnt > 0u ? cnt : 1u;
}
__device__ __forceinline__ void xcd_barrier(const XcdBarrier& b, bool t0) {
    asm volatile("s_waitcnt vmcnt(0)" ::: "memory");
    __syncthreads();
    if (t0) {
        unsigned* bar = b.bar;
        __builtin_amdgcn_s_waitcnt(0);
        unsigned nloc = b.st[0], nx = b.st[1];
        if (nloc == 0u) { xcd_barrier_complete(bar, b.x, nloc, nx); b.st[0] = nloc; b.st[1] = nx; }
        const unsigned old = xb_add(&bar[XB_XSUB(b.x)], 1u);
        const unsigned gen = old / nloc;
        if (old + 1u == (gen + 1u) * nloc) {
            __builtin_amdgcn_fence(__ATOMIC_RELEASE, "agent");
            asm volatile("s_waitcnt vmcnt(0)" ::: "memory");
            const unsigned og = xb_add(&bar[XB_TOP], 1u);
            const unsigned tg = og / nx;
            if (og + 1u == (tg + 1u) * nx) xb_add(&bar[XB_TOPGEN], 1u);
            else XB_SPIN(xb_ld(&bar[XB_TOPGEN]) == tg, bar);
            __builtin_amdgcn_fence(__ATOMIC_ACQUIRE, "agent");
            xb_add(&bar[XB_XGEN(b.x)], 1u);
            asm volatile("s_waitcnt vmcnt(0)" ::: "memory");
        } else {
            XB_SPIN(xb_ld(&bar[XB_XGEN(b.x)]) == gen, bar);
            __builtin_amdgcn_fence(__ATOMIC_ACQUIRE, "agent");
            asm volatile("s_waitcnt vmcnt(0)" ::: "memory");
        }
    }
    __syncthreads();
}

__device__ __forceinline__ void transpose_item(const float* W, int N, int K, bf16* WT, int k0, int n0, int drow0, const float* gk, LAS float* scr, int lane) {
    { const int kr = lane >> 3, q4 = 4 * (lane & 7); f32x4 v[8]; float g[8];
#pragma unroll
      for (int i = 0; i < 8; ++i) { v[i] = *(const f32x4*)(W + (size_t)(k0 + 8 * i + kr) * N + n0 + q4); g[i] = gk ? gk[k0 + 8 * i + kr] : 1.f; }
#pragma unroll
      for (int i = 0; i < 8; ++i) { LAS float* d = scr + (8 * i + kr) * 33 + q4; d[0] = v[i].x * g[i]; d[1] = v[i].y * g[i]; d[2] = v[i].z * g[i]; d[3] = v[i].w * g[i]; } }
    LDS_WAIT(); asm volatile("" ::: "memory");
    const int c = lane & 7;
#pragma unroll
    for (int j = 0; j < 4; ++j) { const int n = (lane >> 3) + 8 * j; const LAS float* s = scr + (8 * c) * 33 + n;
        u32x4 o; o.x = pk2(s[0 * 33], s[1 * 33]); o.y = pk2(s[2 * 33], s[3 * 33]); o.z = pk2(s[4 * 33], s[5 * 33]); o.w = pk2(s[6 * 33], s[7 * 33]);
        *(u32x4*)(WT + (size_t)(drow0 + n) * K + k0 + 8 * c) = o; }
    LDS_WAIT(); asm volatile("" ::: "memory");
}
__device__ __forceinline__ void transpose_item8(const float* W, int N, int K, unsigned char* WT, int k0, int n0, int drow0, float sc, LAS float* scr, int lane) {
    { const int kr = lane >> 3, q4 = 4 * (lane & 7); f32x4 v[16];
#pragma unroll
      for (int i = 0; i < 16; ++i) v[i] = *(const f32x4*)(W + (size_t)(k0 + 8 * i + kr) * N + n0 + q4);
#pragma unroll
      for (int i = 0; i < 16; ++i) { LAS float* d = scr + (8 * i + kr) * 33 + q4; d[0] = v[i].x; d[1] = v[i].y; d[2] = v[i].z; d[3] = v[i].w; } }
    LDS_WAIT(); asm volatile("" ::: "memory");
    const int c = lane & 7;
#pragma unroll
    for (int j = 0; j < 4; ++j) { const int n = (lane >> 3) + 8 * j; const LAS float* s = scr + (16 * c) * 33 + n;
        u32x4 o; o.x = pk4_fp8(sc * s[0 * 33], sc * s[1 * 33], sc * s[2 * 33], sc * s[3 * 33]); o.y = pk4_fp8(sc * s[4 * 33], sc * s[5 * 33], sc * s[6 * 33], sc * s[7 * 33]);
        o.z = pk4_fp8(sc * s[8 * 33], sc * s[9 * 33], sc * s[10 * 33], sc * s[11 * 33]); o.w = pk4_fp8(sc * s[12 * 33], sc * s[13 * 33], sc * s[14 * 33], sc * s[15 * 33]);
        *(u32x4*)(WT + (size_t)(drow0 + n) * K + k0 + 16 * c) = o; }
    LDS_WAIT(); asm volatile("" ::: "memory");
}
__device__ __forceinline__ int conv_mat8(const float* W, int K, int N, unsigned char* WT, int nb, size_t sstride, size_t dstride, int mode, float sc, LAS float* scr, int gw, int NGW, int rot, int lane) {
    const int nblk = N / 32, per = (K / 128) * nblk, total = per * nb;
    int start = gw - rot; if (start < 0) start += NGW;
    for (int it = start; it < total; it += NGW) {
        const int bi = it / per, r = it - bi * per, kb = r / nblk, nbk = r - kb * nblk, n0 = 32 * nbk;
        const int drow0 = mode == 0 ? n0 : ((n0 >> 7) * 256 + (n0 & 127) + (mode == 2 ? 128 : 0));
        transpose_item8(W + (size_t)bi * sstride, N, K, WT + (size_t)bi * dstride, 128 * kb, n0, drow0, sc, scr, lane);
    }
    return (rot + total) % NGW;
}
__device__ __forceinline__ void transpose_item_i8(const float* W, int N, int K, unsigned char* WT, int k0, int n0, int drow0, float sc, const float* gk, LAS float* scr, int lane) {
    { const int kr = lane >> 3, q4 = 4 * (lane & 7); f32x4 v[16]; float g[16];
#pragma unroll
      for (int i = 0; i < 16; ++i) { v[i] = *(const f32x4*)(W + (size_t)(k0 + 8 * i + kr) * N + n0 + q4); g[i] = gk ? gk[k0 + 8 * i + kr] * sc : sc; }
#pragma unroll
      for (int i = 0; i < 16; ++i) { LAS float* d = scr + (8 * i + kr) * 33 + q4; d[0] = v[i].x * g[i]; d[1] = v[i].y * g[i]; d[2] = v[i].z * g[i]; d[3] = v[i].w * g[i]; } }
    LDS_WAIT(); asm volatile("" ::: "memory");
    const int c = lane & 7;
#pragma unroll
    for (int j = 0; j < 4; ++j) { const int n = (lane >> 3) + 8 * j; const LAS float* s = scr + (16 * c) * 33 + n;
        u32x4 o; o.x = pk4_i8(s[0 * 33], s[1 * 33], s[2 * 33], s[3 * 33]); o.y = pk4_i8(s[4 * 33], s[5 * 33], s[6 * 33], s[7 * 33]);
        o.z = pk4_i8(s[8 * 33], s[9 * 33], s[10 * 33], s[11 * 33]); o.w = pk4_i8(s[12 * 33], s[13 * 33], s[14 * 33], s[15 * 33]);
        *(u32x4*)(WT + (size_t)(drow0 + n) * K + k0 + 16 * c) = o; }
    LDS_WAIT(); asm volatile("" ::: "memory");
}
__device__ __forceinline__ int conv_mat_i8(const float* W, int K, int N, unsigned char* WT, int mode, float sc, const float* gk, LAS float* scr, int gw, int NGW, int rot, int lane) {
    const int nblk = N / 32, total = (K / 128) * nblk;
    int start = gw - rot; if (start < 0) start += NGW;
    for (int it = start; it < total; it += NGW) {
        const int kb = it / nblk, nbk = it - kb * nblk, n0 = 32 * nbk;
        const int drow0 = mode == 0 ? n0 : ((n0 >> 7) * 256 + (n0 & 127) + (mode == 2 ? 128 : 0));
        transpose_item_i8(W, N, K, WT, 128 * kb, n0, drow0, sc, gk, scr, lane);
    }
    return (rot + total) % NGW;
}
__device__ __forceinline__ void absmax_mat(const float* W, int K, int N, const float* gk, unsigned* dst, int gt, int NGT, int lane) {
    float mx = 0.f; const int n4 = N / 4, tot = K * n4;
    for (int i0 = gt; i0 < tot; i0 += 8 * NGT) {
        f32x4 v[8]; float g[8];
#pragma unroll
        for (int u = 0; u < 8; ++u) { const int i = i0 + u * NGT; const bool ok = i < tot; v[u] = ok ? ((const f32x4*)W)[i] : (f32x4){0.f, 0.f, 0.f, 0.f}; g[u] = (ok && gk) ? fabsf(gk[i / n4]) : 1.f; }
#pragma unroll
        for (int u = 0; u < 8; ++u) mx = fmaxf(mx, fmaxf(fmaxf(fabsf(v[u].x), fabsf(v[u].y)), fmaxf(fabsf(v[u].z), fabsf(v[u].w))) * g[u]);
    }
    mx = wave_max(mx);
    if (lane == 0) __hip_atomic_fetch_max(dst, __float_as_uint(mx), __ATOMIC_RELAXED, __HIP_MEMORY_SCOPE_AGENT);
}
__device__ __forceinline__ int conv_mat(const float* W, int K, int N, bf16* WT, int nb, size_t sstride, size_t dstride, int mode, const float* gk, LAS float* scr, int gw, int NGW, int rot, int lane) {
    const int nblk = N / 32, per = (K / 64) * nblk, total = per * nb;
    int start = gw - rot; if (start < 0) start += NGW;
    for (int it = start; it < total; it += NGW) {
        const int bi = it / per, r = it - bi * per, kb = r / nblk, nbk = r - kb * nblk, n0 = 32 * nbk;
        const int drow0 = mode == 0 ? n0 : ((n0 >> 7) * 256 + (n0 & 127) + (mode == 2 ? 128 : 0));
        transpose_item(W + (size_t)bi * sstride, N, K, WT + (size_t)bi * dstride, 64 * kb, n0, drow0, gk ? gk + (size_t)bi * K : nullptr, scr, lane);
    }
    return (rot + total) % NGW;
}
__device__ __forceinline__ void p0_prologue(LAS unsigned char* lds, int vcu, int G, int wv) {
    OPAQUE_TID(); OPAQUE_U(vcu); OPAQUE_U(G);
    LAS float* scr = (LAS float*)(lds + wave * 17408);
    const int gw = vcu * NWAVES + wave, NGW = G * NWAVES;
    unsigned char* ws = arg_ws();
    int rot = 0;
    { const int gt0 = vcu * (NWAVES * 64) + tid, NGT0 = G * NWAVES * 64; unsigned* wm = (unsigned*)(ws + WS_CTL) + CW_WMAX;
      if (I8_INPROJ) { absmax_mat(arg_in(2), D, INC, arg_in(1), wm + 0, gt0, NGT0, lane); absmax_mat(arg_in(2) + (size_t)D * INC, D, INC, arg_in(1) + D, wm + 64, gt0, NGT0, lane); }
      if (I8_FFN1) { absmax_mat(arg_in(23), D, DFF, arg_in(22), wm + 128, gt0, NGT0, lane); absmax_mat(arg_in(24), D, DFF, arg_in(22), wm + 128, gt0, NGT0, lane); }
      if (I8_OUTPROJ) { absmax_mat(arg_in(21), D, D, nullptr, wm + 192, gt0, NGT0, lane); absmax_mat(arg_in(21) + (size_t)D * D, D, D, nullptr, wm + 256, gt0, NGT0, lane); } }
    if (F8_FFN2) rot = conv_mat8(arg_in(25), DFF, D, ws + WS_WD, 1, 0, 0, 0, (float)(1 << SC_WD8), scr, gw, NGW, rot, lane);
    else rot = conv_mat(arg_in(25), DFF, D, (bf16*)(ws + WS_WD), 1, 0, 0, 0, nullptr, scr, gw, NGW, rot, lane);
    if (!I8_INPROJ) rot = conv_mat(arg_in(2), D, INC, (bf16*)(ws + WS_WIN), 2, (size_t)D * INC, (size_t)INC * D, 0, arg_in(1), scr, gw, NGW, rot, lane);
    if (!I8_OUTPROJ) rot = conv_mat(arg_in(21), D, D, (bf16*)(ws + WS_WOUT), 2, (size_t)D * D, (size_t)D * D, 0, nullptr, scr, gw, NGW, rot, lane);
    if (!I8_FFN1) { rot = conv_mat(arg_in(23), D, DFF, (bf16*)(ws + WS_WGU), 1, 0, 0, 1, arg_in(22), scr, gw, NGW, rot, lane); rot = conv_mat(arg_in(24), D, DFF, (bf16*)(ws + WS_WGU), 1, 0, 0, 2, arg_in(22), scr, gw, NGW, rot, lane); }
    rot = conv_mat8(arg_in(27), D, DFE, ws + WS_MGU8, NE, (size_t)D * DFE, (size_t)2 * DFE * D, 1, (float)(1 << SC_WGU8), scr, gw, NGW, rot, lane);
    rot = conv_mat8(arg_in(28), D, DFE, ws + WS_MGU8, NE, (size_t)D * DFE, (size_t)2 * DFE * D, 2, (float)(1 << SC_WGU8), scr, gw, NGW, rot, lane);
    rot = conv_mat8(arg_in(29), DFE, D, ws + WS_MD8, NE, (size_t)DFE * D, (size_t)D * DFE, 0, (float)(1 << SC_WD8), scr, gw, NGW, rot, lane);
    const int gt = vcu * (NWAVES * 64) + tid, NGT = G * NWAVES * 64;
    { bf16* wm = (bf16*)(ws + WS_GWM); const float* src = arg_in(11);
      for (int i = gt; i < 2 * 4 * 128 * 128; i += NGT) { const int s = i & 127, t = (i >> 7) & 127; wm[i] = (bf16)(pk2(s <= t ? src[i] : 0.f, 0.f) & 0xffffu); } }
    { bf16* wat = (bf16*)(ws + WS_WAT); bf16* wxt = (bf16*)(ws + WS_WXT); const float* sa = arg_in(15); const float* sx = arg_in(17);
      for (int i = gt; i < 2 * 4 * 64 * 64; i += NGT) { const int ii = i & 63, j = (i >> 6) & 63, lh = i >> 12; const int si = (lh << 12) + ii * 64 + j;
          wat[i] = (bf16)(pk2(sa[si], 0.f) & 0xffffu); wxt[i] = (bf16)(pk2(sx[si], 0.f) & 0xffffu); } }
    { unsigned* xn8 = (unsigned*)(ws + WS_XN8 + (size_t)NTOK * D); for (int i = gt; i < D / 4; i += NGT) xn8[i] = 0u; }
    { const float* x0 = arg_in(0); bf16* xb = (bf16*)(ws + WS_XB); float* rd = (float*)(ws + WS_RD);
      for (int m0 = 4 * gw; m0 < NTOK; m0 += 4 * NGW) { f32x4 v[4][4];
#pragma unroll
          for (int r = 0; r < 4; ++r)
#pragma unroll
              for (int j = 0; j < 4; ++j) v[r][j] = ((const f32x4*)(x0 + (size_t)(m0 + r) * D) + lane)[64 * j];
#pragma unroll
          for (int r = 0; r < 4; ++r) { unsigned long long* o8 = (unsigned long long*)(xb + (size_t)(m0 + r) * D) + lane; float sq = 0.f;
#pragma unroll
              for (int j = 0; j < 4; ++j) { sq += (v[r][j].x * v[r][j].x + v[r][j].y * v[r][j].y) + (v[r][j].z * v[r][j].z + v[r][j].w * v[r][j].w);
                  o8[64 * j] = (unsigned long long)pk2(v[r][j].x, v[r][j].y) | ((unsigned long long)pk2(v[r][j].z, v[r][j].w) << 32); }
              sq = wave_sum(sq); if (lane == 0) rd[m0 + r] = __builtin_amdgcn_rsqf(sq * (1.f / D) + EPS); } } }
}
__device__ __forceinline__ void p1_weights_i8(LAS unsigned char* lds, int vcu, int G, int wv, bool proj, bool ffn) {
    OPAQUE_TID();
    LAS float* scr = (LAS float*)(lds + wave * 17408);
    const int gw = vcu * NWAVES + wave, NGW = G * NWAVES;
    unsigned char* ws = arg_ws(); const unsigned* wm = (const unsigned*)(ws + WS_CTL) + CW_WMAX;
    float sc[5];
#pragma unroll
    for (int t = 0; t < 5; ++t) { const float a = __uint_as_float(__hip_atomic_load(wm + 64 * t, RLX_AGENT)); sc[t] = a > 0.f ? 127.f / a : 0.f; }
    int rot = 0;
    if (I8_INPROJ && proj) { rot = conv_mat_i8(arg_in(2), D, INC, ws + WS_WIN, 0, sc[0], arg_in(1), scr, gw, NGW, rot, lane);
        rot = conv_mat_i8(arg_in(2) + (size_t)D * INC, D, INC, ws + WS_WIN + (size_t)INC * D, 0, sc[1], arg_in(1) + D, scr, gw, NGW, rot, lane); }
    if (I8_FFN1 && ffn) { rot = conv_mat_i8(arg_in(23), D, DFF, ws + WS_WGU, 1, sc[2], arg_in(22), scr, gw, NGW, rot, lane);
        rot = conv_mat_i8(arg_in(24), D, DFF, ws + WS_WGU, 2, sc[2], arg_in(22), scr, gw, NGW, rot, lane); }
    if (I8_OUTPROJ && proj) { rot = conv_mat_i8(arg_in(21), D, D, ws + WS_WOUT, 0, sc[3], nullptr, scr, gw, NGW, rot, lane);
        rot = conv_mat_i8(arg_in(21) + (size_t)D * D, D, D, ws + WS_WOUT + (size_t)D * D, 0, sc[4], nullptr, scr, gw, NGW, rot, lane); }
}
__device__ __forceinline__ float wscale(int t) { return __uint_as_float(__hip_atomic_load((const unsigned*)(arg_ws() + WS_CTL) + CW_WMAX + 64 * t, RLX_AGENT)) * (1.f / 127.f); }

__device__ __forceinline__ void rs_phase(int vcu, int G, int wv) {
    OPAQUE_TID(); OPAQUE_U(vcu); OPAQUE_U(G);
    const float* ss = (const float*)(arg_ws() + WS_SS); float* rd = (float*)(arg_ws() + WS_RD);
    for (int r = vcu * (NWAVES * 64) + tid; r < NTOK; r += G * NWAVES * 64) { const f32x4* p = (const f32x4*)(ss + (size_t)r * 16); const f32x4 a = p[0], b = p[1], c = p[2], d = p[3];
        const float t = (((a.x + a.y) + (a.z + a.w)) + ((b.x + b.y) + (b.z + b.w))) + (((c.x + c.y) + (c.z + c.w)) + ((d.x + d.y) + (d.z + d.w)));
        rd[r] = __builtin_amdgcn_rsqf(t * (1.f / D) + EPS); }
}
__device__ __forceinline__ void xq_phase(int vcu, int G, int wv) {
    OPAQUE_TID(); OPAQUE_U(vcu); OPAQUE_U(G);
    constexpr int XQR = 8;
    const int gw = vcu * NWAVES + wave, NGW = G * NWAVES;
    const bf16* xb = (const bf16*)(arg_ws() + WS_XB); unsigned char* xq = arg_ws() + WS_XQ; float* rs = (float*)(arg_ws() + WS_RS); float* rd = (float*)(arg_ws() + WS_RD);
    for (int m0 = XQR * gw; m0 < NTOK; m0 += XQR * NGW) {
        u32x2 b[XQR][4];
#pragma unroll
        for (int r = 0; r < XQR; ++r)
#pragma unroll
            for (int j = 0; j < 4; ++j) b[r][j] = ((const u32x2*)(xb + (size_t)(m0 + r) * D) + lane)[64 * j];
        float sq[XQR], mx[XQR];
#pragma unroll
        for (int r = 0; r < XQR; ++r) { sq[r] = 0.f; mx[r] = 0.f;
#pragma unroll
            for (int j = 0; j < 4; ++j) { const float x0 = bf_lo(b[r][j].x), x1 = bf_hi(b[r][j].x), x2 = bf_lo(b[r][j].y), x3 = bf_hi(b[r][j].y);
                sq[r] += (x0 * x0 + x1 * x1) + (x2 * x2 + x3 * x3); mx[r] = fmaxf(mx[r], fmaxf(fmaxf(fabsf(x0), fabsf(x1)), fmaxf(fabsf(x2), fabsf(x3)))); } }
#pragma unroll
        for (int r = 0; r < XQR; ++r) { sq[r] = wave_sum(sq[r]); mx[r] = wave_max(mx[r]); }
#pragma unroll
        for (int r = 0; r < XQR; ++r) { const float qs = mx[r] > 0.f ? 127.f / mx[r] : 0.f; unsigned* q4 = (unsigned*)(xq + (size_t)(m0 + r) * D) + lane;
#pragma unroll
            for (int j = 0; j < 4; ++j) q4[64 * j] = pk4_i8(bf_lo(b[r][j].x) * qs, bf_hi(b[r][j].x) * qs, bf_lo(b[r][j].y) * qs, bf_hi(b[r][j].y) * qs);
            if (lane == 0) { const float d = __builtin_amdgcn_rsqf(sq[r] * (1.f / D) + EPS); rs[m0 + r] = d * mx[r] * (1.f / 127.f); rd[m0 + r] = d; } }
    }
}
__device__ __forceinline__ void norm_router_phase(const float* g, const float* router, LAS unsigned char* lds, int G, int wv) {
    OPAQUE_TID(); OPAQUE_U(G);
    LAS int* lcnt = (LAS int*)(lds + 32768);
    LAS int* lbase = lcnt + 16;
    LAS int* rec_e = lcnt + 32;
    LAS int* rec_p = rec_e + 256;
    LAS float* rec_g = (LAS float*)(rec_p + 256);
    float Rr[4][8][4];
#pragma unroll
    for (int q = 0; q < 4; ++q)
#pragma unroll
        for (int c = 0; c < 4; ++c) { const f32x4* rp = (const f32x4*)(router + (size_t)(4 * lane + 256 * q + c) * NE); const f32x4 a = rp[0], b = rp[1];
            Rr[q][0][c] = a.x; Rr[q][1][c] = a.y; Rr[q][2][c] = a.z; Rr[q][3][c] = a.w; Rr[q][4][c] = b.x; Rr[q][5][c] = b.y; Rr[q][6][c] = b.z; Rr[q][7][c] = b.w; }
    gu32* ctl = (gu32*)(arg_ws() + WS_CTL);
    int* ltok = (int*)(arg_ws() + WS_LTOK); float* lgate = (float*)(arg_ws() + WS_LGATE);
    const bf16* xres = (const bf16*)(arg_ws() + WS_XB); unsigned char* xn8 = arg_ws() + WS_XN8;
    for (int ck = blockIdx.x; ck < NTOK / 128; ck += G) {
        if (tid < 16) lcnt[tid] = 0;
        __syncthreads();
        u32x2 nb[4];
#pragma unroll
        for (int q = 0; q < 4; ++q) nb[q] = ((const u32x2*)(xres + (size_t)(ck * 128 + wave * 16) * D) + lane)[64 * q];
        for (int j = 0; j < 16; ++j) {
            const int tl = wave * 16 + j, m = ck * 128 + tl;
            const f32x4* gr = (const f32x4*)g + lane;
            f32x4 v[4]; float s = 0.f;
#pragma unroll
            for (int q = 0; q < 4; ++q) { const u32x2 b = nb[q]; v[q] = (f32x4){bf_lo(b.x), bf_hi(b.x), bf_lo(b.y), bf_hi(b.y)}; s += (v[q].x * v[q].x + v[q].y * v[q].y) + (v[q].z * v[q].z + v[q].w * v[q].w); }
            if (j < 15) {
#pragma unroll
                for (int q = 0; q < 4; ++q) nb[q] = ((const u32x2*)(xres + (size_t)(m + 1) * D) + lane)[64 * q]; }
            const float rstd = __builtin_amdgcn_rsqf(wave_sum(s) * (1.f / D) + EPS);
            float lg[8];
#pragma unroll
            for (int e = 0; e < 8; ++e) lg[e] = 0.f;
            unsigned* o4 = (unsigned*)(xn8 + (size_t)m * D) + lane; const float s8 = (float)(1 << SC_XN8);
#pragma unroll
            for (int q = 0; q < 4; ++q) { const f32x4 gg = gr[64 * q]; f32x4 h; h.x = v[q].x * rstd * gg.x; h.y = v[q].y * rstd * gg.y; h.z = v[q].z * rstd * gg.z; h.w = v[q].w * rstd * gg.w;
                o4[64 * q] = pk4_fp8(s8 * h.x, s8 * h.y, s8 * h.z, s8 * h.w);
#pragma unroll
                for (int e = 0; e < 8; ++e) lg[e] += (h.x * Rr[q][e][0] + h.y * Rr[q][e][1]) + (h.z * Rr[q][e][2] + h.w * Rr[q][e][3]); }
#pragma unroll
            for (int e = 0; e < 8; ++e) lg[e] = wave_sum(lg[e]);
            int e0 = 0; float l0 = lg[0];
#pragma unroll
            for (int e = 1; e < 8; ++e) if (lg[e] > l0) { l0 = lg[e]; e0 = e; }
            int e1 = -1; float l1 = -INFINITY;
#pragma unroll
            for (int e = 0; e < 8; ++e) if (e != e0 && lg[e] > l1) { l1 = lg[e]; e1 = e; }
            if (lane == 0) { const float ex = __expf(l1 - l0); const float g0 = 1.f / (1.f + ex), g1 = ex / (1.f + ex);
                const int p0 = atomicAdd((int*)(lcnt + e0), 1), p1 = atomicAdd((int*)(lcnt + 8 + e1), 1);
                rec_e[2 * tl] = e0; rec_e[2 * tl + 1] = e1; rec_p[2 * tl] = p0; rec_p[2 * tl + 1] = p1; rec_g[2 * tl] = g0; rec_g[2 * tl + 1] = g1; }
        }
        __syncthreads();
        if (tid < 16) { const int c = lcnt[tid]; lbase[tid] = c ? (int)xb_add((unsigned*)(ctl + CW_MOECNT + 64 * tid), (unsigned)c) : 0; }
        __syncthreads();
        if (tid < 256) { const int tl = tid >> 1, k = tid & 1; const int e = rec_e[tid], li = k * 8 + e; const int pos = lbase[li] + rec_p[tid];
            ltok[(size_t)li * NTOK + pos] = ck * 128 + tl; lgate[(size_t)li * NTOK + pos] = rec_g[tid]; }
        __syncthreads();
    }
}

__device__ __forceinline__ void groupnorm_phase(const float* gg, int vcu, int G, int wv) {
    OPAQUE_TID(); OPAQUE_U(vcu); OPAQUE_U(G);
    const int gw = vcu * NWAVES + wave, NGW = G * NWAVES;
    f32x4 gv[4];
#pragma unroll
    for (int q = 0; q < 4; ++q) gv[q] = *(const f32x4*)(gg + 16 * lane + 4 * q);
    bf16* yb = (bf16*)(arg_ws() + WS_Y); unsigned char* yq = arg_ws() + WS_YQ; float* ysc = (float*)(arg_ws() + WS_YS);
    for (int m0 = 8 * gw; m0 < NTOK; m0 += 8 * NGW) {
        u32x4 w[8][2];
#pragma unroll
        for (int r = 0; r < 8; ++r) { const u32x4* p = (const u32x4*)(yb + (size_t)(m0 + r) * D + 16 * lane); w[r][0] = p[0]; w[r][1] = p[1]; }
#pragma unroll
        for (int r = 0; r < 8; ++r) {
            float v[16];
#pragma unroll
            for (int i = 0; i < 4; ++i) { v[2 * i] = bf_lo(w[r][0][i]); v[2 * i + 1] = bf_hi(w[r][0][i]); v[8 + 2 * i] = bf_lo(w[r][1][i]); v[8 + 2 * i + 1] = bf_hi(w[r][1][i]); }
            float s = 0.f;
#pragma unroll
            for (int i = 0; i < 16; ++i) s += v[i] * v[i];
            s += swz_xor<1>(s); s += swz_xor<2>(s); s += swz_xor<4>(s); s += swz_xor<8>(s);
            const float rstd = __builtin_amdgcn_rsqf(s * (1.f / 256.f) + EPS);
            float mx = 0.f;
#pragma unroll
            for (int i = 0; i < 16; ++i) { v[i] = v[i] * rstd * gv[i >> 2][i & 3]; mx = fmaxf(mx, fabsf(v[i])); }
            if (!I8_OUTPROJ) { u32x4 o0, o1;
#pragma unroll
                for (int i = 0; i < 4; ++i) { o0[i] = pk2(v[2 * i], v[2 * i + 1]); o1[i] = pk2(v[8 + 2 * i], v[8 + 2 * i + 1]); }
                u32x4* pw = (u32x4*)(yb + (size_t)(m0 + r) * D + 16 * lane); pw[0] = o0; pw[1] = o1; }
            else { mx = wave_max(mx); const float qs = mx > 0.f ? 127.f / mx : 0.f;
                u32x4 o; o.x = pk4_i8(v[0] * qs, v[1] * qs, v[2] * qs, v[3] * qs); o.y = pk4_i8(v[4] * qs, v[5] * qs, v[6] * qs, v[7] * qs);
                o.z = pk4_i8(v[8] * qs, v[9] * qs, v[10] * qs, v[11] * qs); o.w = pk4_i8(v[12] * qs, v[13] * qs, v[14] * qs, v[15] * qs);
                *(u32x4*)(yq + (size_t)(m0 + r) * D + 16 * lane) = o;
                if (lane == 0) ysc[m0 + r] = mx * (1.f / 127.f); }
        }
    }
}

constexpr int ATT_K_OFF = 0, ATT_KSTR = 144, ATT_V_OFF = 9216, ATT_VSTR = 136, ATT_DONE_OFF = 18432;
constexpr float ATT_THR = 40.0f;
__device__ __forceinline__ void attn_unit(int layer, int b, int h, int qb, LAS unsigned char* lds, int tid, int lane, int w) {
    const bf16* proj = (const bf16*)(arg_ws() + WS_PROJ);
    bf16* Y = (bf16*)(arg_ws() + WS_Y);
    const float* gq = arg_in(3) + layer * 64; const float* gk = arg_in(4) + layer * 64;
    const int r32 = lane & 31, hi = lane >> 5;
    const int tw0 = qb * 256 + 32 * w, tq = tw0 + r32;
    const size_t tokbase = (size_t)b * SEQ;
    bf16x8 qf[4];
    {
        const bf16* qrow = proj + (tokbase + tq) * INC + C_Q + h * 64 + 8 * hi;
        u32x4 raw[4]; float ss = 0.f;
#pragma unroll
        for (int kk = 0; kk < 4; ++kk) { raw[kk] = *(const u32x4*)(qrow + 16 * kk);
#pragma unroll
            for (int j = 0; j < 4; ++j) { const float x0 = bf_lo(raw[kk][j]), x1 = bf_hi(raw[kk][j]); ss += x0 * x0 + x1 * x1; } }
        ss = sum_halves(ss);
        const float sc = __builtin_amdgcn_rsqf(ss * (1.f / 64.f) + EPS) * (0.125f * LOG2E);
#pragma unroll
        for (int kk = 0; kk < 4; ++kk) { const f32x4 g0 = *(const f32x4*)(gq + 16 * kk + 8 * hi), g1 = *(const f32x4*)(gq + 16 * kk + 8 * hi + 4);
            u32x4 o; o.x = pk2(bf_lo(raw[kk].x) * sc * g0.x, bf_hi(raw[kk].x) * sc * g0.y); o.y = pk2(bf_lo(raw[kk].y) * sc * g0.z, bf_hi(raw[kk].y) * sc * g0.w);
            o.z = pk2(bf_lo(raw[kk].z) * sc * g1.x, bf_hi(raw[kk].z) * sc * g1.y); o.w = pk2(bf_lo(raw[kk].w) * sc * g1.z, bf_hi(raw[kk].w) * sc * g1.w);
            qf[kk] = __builtin_bit_cast(bf16x8, o); }
    }
    const int sr = tid >> 3, sc8 = tid & 7;
    const f32x4 gk0 = *(const f32x4*)(gk + 8 * sc8), gk1 = *(const f32x4*)(gk + 8 * sc8 + 4);
    f32x16 o0, o1;
#pragma unroll
    for (int i = 0; i < 16; ++i) { o0[i] = 0.f; o1[i] = 0.f; }
    float run = 0.f;
    LAS unsigned* done_cnt = (LAS unsigned*)(lds + ATT_DONE_OFF);
    bool wdone = false;
    if (tid == 0) *done_cnt = 0u;
    const int jt = 4 * qb + 3;
    u32x4 kraw, vraw;
    { const bf16* p = proj + (tokbase + 64 * jt + sr) * INC + h * 64 + 8 * sc8; kraw = *(const u32x4*)(p + C_K); vraw = *(const u32x4*)(p + C_V); }
    for (int j = jt; j >= 0; --j) {
        {
            float kv[8];
#pragma unroll
            for (int i = 0; i < 4; ++i) { kv[2 * i] = bf_lo(kraw[i]); kv[2 * i + 1] = bf_hi(kraw[i]); }
            float ss = 0.f;
#pragma unroll
            for (int i = 0; i < 8; ++i) ss += kv[i] * kv[i];
            ss += swz_xor<1>(ss); ss += swz_xor<2>(ss); ss += swz_xor<4>(ss);
            const float rs = __builtin_amdgcn_rsqf(ss * (1.f / 64.f) + EPS);
            u32x4 o; o.x = pk2(kv[0] * rs * gk0.x, kv[1] * rs * gk0.y); o.y = pk2(kv[2] * rs * gk0.z, kv[3] * rs * gk0.w); o.z = pk2(kv[4] * rs * gk1.x, kv[5] * rs * gk1.y); o.w = pk2(kv[6] * rs * gk1.z, kv[7] * rs * gk1.w);
            *(LAS u32x4*)(lds + ATT_K_OFF + sr * ATT_KSTR + sc8 * 16) = o;
#pragma unroll
            for (int i = 0; i < 8; ++i) *(LAS unsigned short*)(lds + ATT_V_OFF + (8 * sc8 + i) * ATT_VSTR + sr * 2) = (unsigned short)((vraw[i >> 1] >> (16 * (i & 1))) & 0xffffu);
        }
        __syncthreads();
        if (j > 0) { const bf16* p = proj + (tokbase + 64 * (j - 1) + sr) * INC + h * 64 + 8 * sc8; kraw = *(const u32x4*)(p + C_K); vraw = *(const u32x4*)(p + C_V); }
        if (!wdone && 64 * j <= tw0 + 30) {
            f32x16 p0, p1;
#pragma unroll
            for (int i = 0; i < 16; ++i) { p0[i] = 0.f; p1[i] = 0.f; }
#pragma unroll
            for (int kk = 0; kk < 4; ++kk) {
                const bf16x8 k0 = *(const LAS bf16x8*)(lds + ATT_K_OFF + r32 * ATT_KSTR + (16 * kk + 8 * hi) * 2);
                const bf16x8 k1 = *(const LAS bf16x8*)(lds + ATT_K_OFF + (32 + r32) * ATT_KSTR + (16 * kk + 8 * hi) * 2);
                p0 = __builtin_amdgcn_mfma_f32_32x32x16_bf16(k0, qf[kk], p0, 0, 0, 0);
                p1 = __builtin_amdgcn_mfma_f32_32x32x16_bf16(k1, qf[kk], p1, 0, 0, 0);
            }
            const bool diag = (64 * j + 63 >= tw0);
            if (diag) {
                const int lim = tq - 64 * j - 4 * hi;
#pragma unroll
                for (int r = 0; r < 16; ++r) { if ((r & 3) + 8 * (r >> 2) >= lim) p0[r] = -INFINITY; if (32 + (r & 3) + 8 * (r >> 2) >= lim) p1[r] = -INFINITY; } }
            float sp[2][16];
#pragma unroll
            for (int kb = 0; kb < 2; ++kb)
#pragma unroll
                for (int r = 0; r < 16; ++r) { const float z = kb ? p1[r] : p0[r];
                    float s = __builtin_amdgcn_logf(1.0f + __builtin_amdgcn_exp2f(z));
                    sp[kb][r] = s; }
            float Gt[2][4], Gh[2][4];
#pragma unroll
            for (int kb = 0; kb < 2; ++kb)
#pragma unroll
                for (int g = 0; g < 4; ++g) { const float gs = (sp[kb][4 * g] + sp[kb][4 * g + 1]) + (sp[kb][4 * g + 2] + sp[kb][4 * g + 3]); float lo, hh; halves(gs, lo, hh); Gt[kb][g] = lo + hh; Gh[kb][g] = hh; }
            float suf = run;
            u32x4 pw[4];
#pragma unroll
            for (int kb = 1; kb >= 0; --kb)
#pragma unroll
                for (int g = 3; g >= 0; --g) {
                    const float base = suf + (hi == 0 ? Gh[kb][g] : 0.f);
                    const float c3 = base + sp[kb][4 * g + 3], c2 = c3 + sp[kb][4 * g + 2], c1 = c2 + sp[kb][4 * g + 1], c0 = c1 + sp[kb][4 * g];
                    const float z0 = kb ? p1[4 * g] : p0[4 * g], z1 = kb ? p1[4 * g + 1] : p0[4 * g + 1], z2 = kb ? p1[4 * g + 2] : p0[4 * g + 2], z3 = kb ? p1[4 * g + 3] : p0[4 * g + 3];
                    float w0 = __builtin_amdgcn_exp2f(z0 - c0), w1 = __builtin_amdgcn_exp2f(z1 - c1), w2 = __builtin_amdgcn_exp2f(z2 - c2), w3 = __builtin_amdgcn_exp2f(z3 - c3);
                    const int ks = 2 * kb + (g >> 1);
                    if (g & 1) { pw[ks].z = pk2(w0, w1); pw[ks].w = pk2(w2, w3); } else { pw[ks].x = pk2(w0, w1); pw[ks].y = pk2(w2, w3); }
                    suf += Gt[kb][g];
                }
            run = suf;
            if (__all(run >= ATT_THR)) { wdone = true; if (lane == 0) atomicAdd((unsigned*)done_cnt, 1u); }
#pragma unroll
            for (int ks = 0; ks < 4; ++ks) {
                const bf16x8 pb = __builtin_bit_cast(bf16x8, pw[ks]);
#pragma unroll
                for (int db = 0; db < 2; ++db) {
                    const LAS unsigned char* vp = lds + ATT_V_OFF + (32 * db + r32) * ATT_VSTR + (16 * ks + 4 * hi) * 2;
                    const u32x2 lo = *(const LAS u32x2*)vp, hh = *(const LAS u32x2*)(vp + 16);
                    u32x4 av; av.x = lo.x; av.y = lo.y; av.z = hh.x; av.w = hh.y;
                    if (db == 0) o0 = __builtin_amdgcn_mfma_f32_32x32x16_bf16(__builtin_bit_cast(bf16x8, av), pb, o0, 0, 0, 0);
                    else o1 = __builtin_amdgcn_mfma_f32_32x32x16_bf16(__builtin_bit_cast(bf16x8, av), pb, o1, 0, 0, 0);
                }
            }
        }
        __syncthreads();
        if (*done_cnt == 8u) break;
    }
    __syncthreads();
    bf16* yrow = Y + (tokbase + tq) * D + h * 64 + 4 * hi;
#pragma unroll
    for (int g = 0; g < 4; ++g) {
        u32x2 s0; s0.x = pk2(o0[4 * g], o0[4 * g + 1]); s0.y = pk2(o0[4 * g + 2], o0[4 * g + 3]); *(u32x2*)(yrow + 8 * g) = s0;
        u32x2 s1; s1.x = pk2(o1[4 * g], o1[4 * g + 1]); s1.y = pk2(o1[4 * g + 2], o1[4 * g + 3]); *(u32x2*)(yrow + 32 + 8 * g) = s1;
    }
}
__device__ __forceinline__ void attn_phase(int layer, LAS unsigned char* lds, int G, int wv) {
    OPAQUE_TID(); OPAQUE_U(G); OPAQUE_U(layer);
    for (int i = blockIdx.x; i < 512; i += G) {
        const int idx = i < 256 ? i : 767 - i;
        const int qb = 7 - (idx >> 6), bh = idx & 63;
        attn_unit(layer, bh >> 2, bh & 3, qb, lds, tid, lane, wave);
    }
}

constexpr int CF_H_OFF = 0, CF_Y_OFF = 81920;
__device__ __forceinline__ void conf_unit(int layer, int b, int c, LAS unsigned char* lds, int tid, int lane, int w) {
    const bf16* proj = (const bf16*)(arg_ws() + WS_PROJ);
    bf16* Y = (bf16*)(arg_ws() + WS_Y);
    const size_t tokbase = (size_t)b * SEQ; const int t0 = 128 * c;
    { const int cq = tid & 31, rr = tid >> 5;
#pragma unroll
      for (int hb = 0; hb < 2; ++hb) {
          u32x4 vv[5], gg[5];
#pragma unroll
          for (int ps = 0; ps < 5; ++ps) { const int i = (5 * hb + ps) * 16 + rr, pos = t0 - 30 + i; vv[ps] = (u32x4){0u, 0u, 0u, 0u}; gg[ps] = vv[ps];
              if (i < 158 && pos >= 0) { const bf16* p = proj + (tokbase + pos) * INC + 8 * cq; vv[ps] = *(const u32x4*)(p + C_CV); gg[ps] = *(const u32x4*)(p + C_CG); } }
#pragma unroll
          for (int ps = 0; ps < 5; ++ps) { const int i = (5 * hb + ps) * 16 + rr; u32x4 o;
#pragma unroll
              for (int q = 0; q < 4; ++q) o[q] = pk2(bf_lo(vv[ps][q]) * fast_sigmoid(bf_lo(gg[ps][q])), bf_hi(vv[ps][q]) * fast_sigmoid(bf_hi(gg[ps][q])));
              if (i < 158) *(LAS u32x4*)(lds + CF_H_OFF + i * 512 + cq * 16) = o; } } }
    __syncthreads();
    const int cp = tid & 127, tg = tid >> 7;
    const float* cw = arg_in(5) + (size_t)layer * 31 * 256 + 2 * cp;
    float w0[31], w1[31];
#pragma unroll
    for (int k = 0; k < 31; ++k) { const f32x2 t = *(const f32x2*)(cw + k * 256); w0[k] = t.x; w1[k] = t.y; }
    const f32x2 cb = *(const f32x2*)(arg_in(6) + layer * 256 + 2 * cp);
    const f32x4 lg = *(const f32x4*)(arg_in(7) + layer * 256 + 4 * lane), lb = *(const f32x4*)(arg_in(8) + layer * 256 + 4 * lane);
    for (int ps = 0; ps < 4; ++ps) {
        const int tl0 = 32 * ps + 8 * tg;
        float a0[8], a1[8];
#pragma unroll
        for (int o = 0; o < 8; ++o) { a0[o] = cb.x; a1[o] = cb.y; }
#pragma unroll
        for (int q = 0; q < 38; ++q) { const unsigned dw = *(const LAS unsigned*)(lds + CF_H_OFF + (tl0 + q) * 512 + cp * 4); const float x0 = bf_lo(dw), x1 = bf_hi(dw);
#pragma unroll
            for (int o = 0; o < 8; ++o) { if (q - o >= 0 && q - o <= 30) { a0[o] += w0[q - o] * x0; a1[o] += w1[q - o] * x1; } } }
#pragma unroll
        for (int o = 0; o < 8; ++o) *(LAS f32x2*)(lds + CF_Y_OFF + ((8 * tg + o) * 256 + 2 * cp) * 4) = (f32x2){a0[o], a1[o]};
        __syncthreads();
#pragma unroll
        for (int r = 0; r < 4; ++r) { const int row = 4 * w + r; const f32x4 v = *(const LAS f32x4*)(lds + CF_Y_OFF + (row * 256 + 4 * lane) * 4);
            const float mean = wave_sum((v.x + v.y) + (v.z + v.w)) * (1.f / 256.f);
            const f32x4 d = v - mean; const float var = wave_sum((d.x * d.x + d.y * d.y) + (d.z * d.z + d.w * d.w)) * (1.f / 256.f);
            const float rstd = __builtin_amdgcn_rsqf(var + EPS);
            f32x4 y = d * rstd * lg + lb;
            y.x *= fast_sigmoid(y.x); y.y *= fast_sigmoid(y.y); y.z *= fast_sigmoid(y.z); y.w *= fast_sigmoid(y.w);
            u32x2 o; o.x = pk2(y.x, y.y); o.y = pk2(y.z, y.w);
            *(u32x2*)(Y + (tokbase + t0 + 32 * ps + row) * D + 256 + 4 * lane) = o; }
        __syncthreads();
    }
}
__device__ __forceinline__ void conf_phase(int layer, LAS unsigned char* lds, int G, int wv) {
    OPAQUE_TID(); OPAQUE_U(G); OPAQUE_U(layer);
    for (int i = blockIdx.x; i < 256; i += G) conf_unit(layer, i >> 4, i & 15, lds, tid, lane, wave);
}

constexpr int GM_U_OFF = 0, GM_USTR = 520, GM_V_OFF = 66560, GM_VSTR = 272;
__device__ __forceinline__ void gmlp_unit(int layer, int b, int c, LAS unsigned char* lds, int tid, int lane, int w) {
    const bf16* proj = (const bf16*)(arg_ws() + WS_PROJ);
    bf16* Y = (bf16*)(arg_ws() + WS_Y);
    const size_t tokbase = (size_t)b * SEQ; const int t0 = 128 * c;
    const f32x4 lg = *(const f32x4*)(arg_in(9) + layer * 256 + 4 * lane), lb = *(const f32x4*)(arg_in(10) + layer * 256 + 4 * lane);
    u32x2 urs[16], vrs[16];
#pragma unroll
    for (int j = 0; j < 16; ++j) { const bf16* p = proj + (tokbase + t0 + 16 * w + j) * INC + 4 * lane; urs[j] = *(const u32x2*)(p + C_GU); vrs[j] = *(const u32x2*)(p + C_GV); }
#pragma unroll
    for (int j = 0; j < 16; ++j) { const int t = 16 * w + j;
        const u32x2 ur = urs[j], vr = vrs[j];
        u32x2 uo; uo.x = pk2(gelu_tanh(bf_lo(ur.x)), gelu_tanh(bf_hi(ur.x))); uo.y = pk2(gelu_tanh(bf_lo(ur.y)), gelu_tanh(bf_hi(ur.y)));
        *(LAS u32x2*)(lds + GM_U_OFF + t * GM_USTR + lane * 8) = uo;
        f32x4 v; v.x = gelu_tanh(bf_lo(vr.x)); v.y = gelu_tanh(bf_hi(vr.x)); v.z = gelu_tanh(bf_lo(vr.y)); v.w = gelu_tanh(bf_hi(vr.y));
        const float mean = wave_sum((v.x + v.y) + (v.z + v.w)) * (1.f / 256.f);
        const f32x4 d = v - mean; const float var = wave_sum((d.x * d.x + d.y * d.y) + (d.z * d.z + d.w * d.w)) * (1.f / 256.f);
        const float rstd = __builtin_amdgcn_rsqf(var + EPS);
        const f32x4 y = d * rstd * lg + lb;
        const unsigned q0 = pk2(y.x, y.y), q1 = pk2(y.z, y.w);
        LAS unsigned char* vp = lds + GM_V_OFF + (4 * lane) * GM_VSTR + t * 2;
        *(LAS unsigned short*)(vp) = (unsigned short)(q0 & 0xffffu); *(LAS unsigned short*)(vp + GM_VSTR) = (unsigned short)(q0 >> 16);
        *(LAS unsigned short*)(vp + 2 * GM_VSTR) = (unsigned short)(q1 & 0xffffu); *(LAS unsigned short*)(vp + 3 * GM_VSTR) = (unsigned short)(q1 >> 16); }
    __syncthreads();
    const int fr = lane & 15, fq = lane >> 4, t = 16 * w + fr;
    const int nks = (w >> 1) + 1;
    const bf16* wm = (const bf16*)(arg_ws() + WS_GWM) + (size_t)layer * 4 * 128 * 128;
    const float* bs = arg_in(12) + layer * 4 * 128;
#pragma unroll
    for (int h = 0; h < 4; ++h) {
        bf16x8 bfr[4];
#pragma unroll
        for (int ks = 0; ks < 4; ++ks) { if (ks < nks) bfr[ks] = *(const bf16x8*)(wm + ((size_t)h * 128 + t) * 128 + 32 * ks + 8 * fq); else bfr[ks] = (bf16x8){0, 0, 0, 0, 0, 0, 0, 0}; }
        const float bsv = bs[h * 128 + t];
#pragma unroll
        for (int dt = 0; dt < 4; ++dt) {
            f32x4 acc = (f32x4){0.f, 0.f, 0.f, 0.f};
#pragma unroll
            for (int ks = 0; ks < 4; ++ks) { if (ks < nks) { const bf16x8 af = *(const LAS bf16x8*)(lds + GM_V_OFF + (64 * h + 16 * dt + fr) * GM_VSTR + (32 * ks + 8 * fq) * 2);
                    acc = __builtin_amdgcn_mfma_f32_16x16x32_bf16(af, bfr[ks], acc, 0, 0, 0); } }
            const u32x2 uu = *(const LAS u32x2*)(lds + GM_U_OFF + t * GM_USTR + (64 * h + 16 * dt + 4 * fq) * 2);
            u32x2 o; o.x = pk2(bf_lo(uu.x) * (acc[0] + bsv), bf_hi(uu.x) * (acc[1] + bsv)); o.y = pk2(bf_lo(uu.y) * (acc[2] + bsv), bf_hi(uu.y) * (acc[3] + bsv));
            *(u32x2*)(Y + (tokbase + t0 + t) * D + 512 + 64 * h + 16 * dt + 4 * fq) = o;
        }
    }
    __syncthreads();
}
__device__ __forceinline__ void gmlp_phase(int layer, LAS unsigned char* lds, int G, int wv) {
    OPAQUE_TID(); OPAQUE_U(G); OPAQUE_U(layer);
    for (int i = blockIdx.x; i < 256; i += G) gmlp_unit(layer, i >> 4, i & 15, lds, tid, lane, wave);
}

constexpr int LR_R0 = 0;
constexpr int LR_XB = 37376;
constexpr int LR_XF = 74240;
constexpr int LR_GT = 90624;
constexpr int LR_YO = 109056;
__device__ __forceinline__ int lr_sw(int t) { return t + (t >> 3); }
__device__ __forceinline__ void lru_unit(int layer, int b, int h, int qt, LAS unsigned char* lds, int tid, int lane, int w) {
    const bf16* proj = (const bf16*)(arg_ws() + WS_PROJ);
    bf16* Y = (bf16*)(arg_ws() + WS_Y);
    const size_t tokbase = (size_t)b * SEQ;
    const int chb = 64 * h;
    const int c8 = tid & 7, tr = tid >> 3;
    const int fr = lane & 15, fq = lane >> 4;
    float cwo[4][4], cbo[4];
    { const float* cwp = arg_in(13) + (size_t)layer * 4 * 256 + chb + 16 * qt + 4 * fq;
#pragma unroll
      for (int k = 0; k < 4; ++k) { const f32x4 x = *(const f32x4*)(cwp + k * 256); cwo[k][0] = x.x; cwo[k][1] = x.y; cwo[k][2] = x.z; cwo[k][3] = x.w; }
      const f32x4 y = *(const f32x4*)(arg_in(14) + layer * 256 + chb + 16 * qt + 4 * fq); cbo[0] = y.x; cbo[1] = y.y; cbo[2] = y.z; cbo[3] = y.w; }
    bf16x8 afa[4][2], afx[4][2];
    float pa = 0.f, px = 0.f;
    { const bf16* wat = (const bf16*)(arg_ws() + WS_WAT) + ((size_t)(layer * 4 + h) * 64 + 16 * qt + fr) * 64 + 8 * fq;
      const bf16* wxt = (const bf16*)(arg_ws() + WS_WXT) + ((size_t)(layer * 4 + h) * 64 + 16 * qt + fr) * 64 + 8 * fq;
#pragma unroll
      for (int ks = 0; ks < 2; ++ks) { const u32x4 ra = *(const u32x4*)(wat + 32 * ks), rx = *(const u32x4*)(wxt + 32 * ks);
          float fa[8], fx[8];
#pragma unroll
          for (int e = 0; e < 4; ++e) { fa[2 * e] = bf_lo(ra[e]); fa[2 * e + 1] = bf_hi(ra[e]); fx[2 * e] = bf_lo(rx[e]); fx[2 * e + 1] = bf_hi(rx[e]); }
          const float* cbp = arg_in(14) + layer * 256 + chb + 32 * ks + 8 * fq; const f32x4 c0 = *(const f32x4*)cbp, c1 = *(const f32x4*)(cbp + 4);
          pa += (fa[0] * c0.x + fa[1] * c0.y) + (fa[2] * c0.z + fa[3] * c0.w) + (fa[4] * c1.x + fa[5] * c1.y) + (fa[6] * c1.z + fa[7] * c1.w);
          px += (fx[0] * c0.x + fx[1] * c0.y) + (fx[2] * c0.z + fx[3] * c0.w) + (fx[4] * c1.x + fx[5] * c1.y) + (fx[6] * c1.z + fx[7] * c1.w);
#pragma unroll
          for (int k = 0; k < 4; ++k) { const float* cwp = arg_in(13) + (size_t)layer * 4 * 256 + k * 256 + chb + 32 * ks + 8 * fq; const f32x4 w0 = *(const f32x4*)cwp, w1 = *(const f32x4*)(cwp + 4);
              u32x4 oa, ox;
              oa.x = pk2(fa[0] * w0.x, fa[1] * w0.y); oa.y = pk2(fa[2] * w0.z, fa[3] * w0.w); oa.z = pk2(fa[4] * w1.x, fa[5] * w1.y); oa.w = pk2(fa[6] * w1.z, fa[7] * w1.w);
              ox.x = pk2(fx[0] * w0.x, fx[1] * w0.y); ox.y = pk2(fx[2] * w0.z, fx[3] * w0.w); ox.z = pk2(fx[4] * w1.x, fx[5] * w1.y); ox.w = pk2(fx[6] * w1.z, fx[7] * w1.w);
              afa[k][ks] = __builtin_bit_cast(bf16x8, oa); afx[k][ks] = __builtin_bit_cast(bf16x8, ox); } } }
    pa = sum_rows16(pa); pa = sum_halves(pa); px = sum_rows16(px); px = sum_halves(px);
    LAS float* bsh = (LAS float*)(lds + LR_YO);
    if (w == 0 && fq == 0) { bsh[fr] = pa; bsh[16 + fr] = px; }
    __syncthreads();
    float bav[4], bxv[4], clv[4];
    { const int ch = layer * 256 + chb + 16 * qt + 4 * fq; const f32x4 x0 = *(const f32x4*)(arg_in(16) + ch), x1 = *(const f32x4*)(arg_in(18) + ch), x2 = *(const f32x4*)(arg_in(19) + ch);
#pragma unroll
      for (int i = 0; i < 4; ++i) { bav[i] = x0[i] + bsh[4 * fq + i]; bxv[i] = x1[i] + bsh[16 + 4 * fq + i]; clv[i] = -8.0f * log1pf(expf(-x2[i])); } }
    const int sc = 2 * w + (lane >> 5), sg = lane & 31;
    float hc = 0.f;
    u32x4 xpre[5], gpre;
#define LR_FETCH(P0) do { _Pragma("unroll") for (int ps = 0; ps < 5; ++ps) { const int i = 64 * ps + tr; const int pos = (P0) - 3 + i; xpre[ps] = (u32x4){0u, 0u, 0u, 0u}; \
            if (i < 259 && pos >= 0) xpre[ps] = *(const u32x4*)(proj + (tokbase + pos) * INC + C_LX + chb + 8 * c8); } \
        gpre = *(const u32x4*)(proj + (tokbase + (P0) + (tid >> 1)) * INC + C_LG + chb + 16 * qt + 8 * (tid & 1)); } while (0)
    LR_FETCH(0);
    for (int it = 0; it < 8; ++it) {
        const int p0 = 256 * it;
#pragma unroll
        for (int ps = 0; ps < 5; ++ps) { const int i = 64 * ps + tr; if (i < 259) *(LAS u32x4*)(lds + LR_R0 + i * 144 + c8 * 16) = xpre[ps]; }
        { const int t = tid >> 1, hf = tid & 1; const u32x4 gr = gpre;
          LAS float* gt = (LAS float*)(lds + LR_GT) + lr_sw(t);
#pragma unroll
          for (int i = 0; i < 4; ++i) { gt[(8 * hf + 2 * i) * 288] = gelu_tanh(bf_lo(gr[i])); gt[(8 * hf + 2 * i + 1) * 288] = gelu_tanh(bf_hi(gr[i])); } }
        __syncthreads();
        if (it < 7) LR_FETCH(p0 + 256);
#pragma unroll
        for (int tt = 0; tt < 2; ++tt) { const int t = 32 * w + 16 * tt + fr;
            f32x4 ca = (f32x4){0.f, 0.f, 0.f, 0.f}, cx = (f32x4){0.f, 0.f, 0.f, 0.f};
            float xf[4];
#pragma unroll
            for (int i = 0; i < 4; ++i) xf[i] = cbo[i];
#pragma unroll
            for (int k = 0; k < 4; ++k) {
#pragma unroll
                for (int ks = 0; ks < 2; ++ks) { const bf16x8 bfr = *(const LAS bf16x8*)(lds + LR_R0 + (t + k) * 144 + (32 * ks + 8 * fq) * 2);
                    ca = __builtin_amdgcn_mfma_f32_16x16x32_bf16(afa[k][ks], bfr, ca, 0, 0, 0); cx = __builtin_amdgcn_mfma_f32_16x16x32_bf16(afx[k][ks], bfr, cx, 0, 0, 0); }
                const u32x2 r = *(const LAS u32x2*)(lds + LR_R0 + (t + k) * 144 + (16 * qt + 4 * fq) * 2);
                xf[0] += cwo[k][0] * bf_lo(r.x); xf[1] += cwo[k][1] * bf_hi(r.x); xf[2] += cwo[k][2] * bf_lo(r.y); xf[3] += cwo[k][3] * bf_hi(r.y); }
            LAS float* aa = (LAS float*)(lds + LR_XB) + lr_sw(t); LAS float* bb = (LAS float*)(lds + LR_XB + 18432) + lr_sw(t);
#pragma unroll
            for (int i = 0; i < 4; ++i) { const float r = fast_sigmoid(ca[i] + bav[i]), ig = fast_sigmoid(cx[i] + bxv[i]); const float la = r * clv[i];
                aa[(4 * fq + i) * 288] = __expf(la); bb[(4 * fq + i) * 288] = __builtin_amdgcn_sqrtf(one_minus_exp(2.0f * la)) * ig * xf[i]; } }
        __syncthreads();
        { const LAS float* aa = (const LAS float*)(lds + LR_XB) + sc * 288; const LAS float* bb = (const LAS float*)(lds + LR_XB + 18432) + sc * 288;
          const LAS float* gt = (const LAS float*)(lds + LR_GT) + sc * 288; LAS float* yo = (LAS float*)(lds + LR_YO) + sc * 288;
          float av[8], bv[8]; float A = 1.f, B = 0.f;
#pragma unroll
          for (int k = 0; k < 8; ++k) { av[k] = aa[9 * sg + k]; bv[k] = bb[9 * sg + k]; B = av[k] * B + bv[k]; A *= av[k]; }
#define LR_SHFL(v, srclane) __int_as_float(__builtin_amdgcn_ds_bpermute((srclane) * 4, __float_as_int(v)))
#pragma unroll
          for (int off = 1; off < 32; off <<= 1) { const int src = sg >= off ? lane - off : lane; const float Ap = LR_SHFL(A, src), Bp = LR_SHFL(B, src); if (sg >= off) { B = A * Bp + B; A = Ap * A; } }
          float Ae = LR_SHFL(A, sg ? lane - 1 : lane), Be = LR_SHFL(B, sg ? lane - 1 : lane); if (sg == 0) { Ae = 1.f; Be = 0.f; }
          float hcur = Ae * hc + Be;
          const float At = LR_SHFL(A, lane | 31), Bt = LR_SHFL(B, lane | 31);
#undef LR_SHFL
          hc = At * hc + Bt;
#pragma unroll
          for (int k = 0; k < 8; ++k) { hcur = av[k] * hcur + bv[k]; yo[9 * sg + k] = hcur * gt[9 * sg + k]; } }
        __syncthreads();
        { const int t = tid >> 1, hf = tid & 1; const LAS float* yo = (const LAS float*)(lds + LR_YO) + lr_sw(t) + (8 * hf) * 288;
          u32x4 o; o.x = pk2(yo[0], yo[288]); o.y = pk2(yo[2 * 288], yo[3 * 288]); o.z = pk2(yo[4 * 288], yo[5 * 288]); o.w = pk2(yo[6 * 288], yo[7 * 288]);
          *(u32x4*)(Y + (tokbase + p0 + t) * D + 768 + chb + 16 * qt + 8 * hf) = o; }
    }
    __syncthreads();
}
#undef LR_FETCH
__device__ __forceinline__ void lru_phase(int layer, LAS unsigned char* lds, int G, int wv) {
    OPAQUE_TID(); OPAQUE_U(G); OPAQUE_U(layer);
    for (int i = blockIdx.x; i < 256; i += G) lru_unit(layer, i >> 4, (i >> 2) & 3, i & 3, lds, tid, lane, wave);
}

constexpr int N_PHASES = 25;
__device__ __forceinline__ void moe_table(LAS unsigned char* lds, int wv) {
    OPAQUE_TID();
    LAS int* tab = (LAS int*)(lds + MOE_TAB);
    if (tid < 16) { gu32* ctl = (gu32*)(arg_ws() + WS_CTL); const int c = (int)__hip_atomic_load(ctl + CW_MOECNT + 64 * tid, RLX_AGENT); tab[tid] = c; tab[40 + tid] = (c + 255) >> 8; }
    __syncthreads();
    if (tid < 17) { int accu = 0; for (int j = 0; j < tid; ++j) accu += tab[40 + j]; tab[16 + tid] = accu; }
    __syncthreads();
}
__device__ __forceinline__ void moe_gather_phase(LAS unsigned char* lds, int vcu, int G, int wv) {
    OPAQUE_TID(); OPAQUE_U(vcu); OPAQUE_U(G);
    moe_table(lds, wv);
    const int gw = vcu * NWAVES + wave, NGW = G * NWAVES;
    const unsigned char* xn8 = arg_ws() + WS_XN8; unsigned char* xg = arg_ws() + WS_XG8; const int* ltok = (const int*)(arg_ws() + WS_LTOK);
    const LAS int* tab = (const LAS int*)(lds + MOE_TAB);
    const int nrows = tab[32] * 256;
    for (int r0 = 8 * gw; r0 < nrows; r0 += 8 * NGW) {
        const int pm = r0 >> 8; int se = 0;
#pragma unroll
        for (int j = 1; j < 16; ++j) se += (pm >= tab[16 + j]) ? 1 : 0;
        const int p0 = r0 - tab[16 + se] * 256, cnt = tab[se];
        int tok[8]; u32x4 v[8];
#pragma unroll
        for (int i = 0; i < 8; ++i) tok[i] = (p0 + i) < cnt ? ltok[(size_t)se * NTOK + p0 + i] : NTOK;
#pragma unroll
        for (int i = 0; i < 8; ++i) v[i] = *(const u32x4*)(xn8 + (size_t)tok[i] * D + 16 * lane);
#pragma unroll
        for (int i = 0; i < 8; ++i) *(u32x4*)(xg + (size_t)(r0 + i) * D + 16 * lane) = v[i];
    }
}
__global__ void __launch_bounds__(NWAVES * 64, 2) fwd_kernel(Args args) {
    extern __shared__ __attribute__((aligned(16))) unsigned char lds_raw[];
    LAS unsigned char* lds = (LAS unsigned char*)lds_raw;
    const int wv = __builtin_amdgcn_readfirstlane((int)threadIdx.x >> 6);
    const int G_ = gridDim.x; const int bx_ = blockIdx.x; const int vcu_ = (G_ % 8 == 0) ? (bx_ % 8) * (G_ / 8) + bx_ / 8 : bx_;
#define G opq_s(G_)
#define bx opq_s(bx_)
#define vcu opq_s(vcu_)
    gu32* ctl = (gu32*)(arg_ws() + WS_CTL);
    for (int u = threadIdx.x; u < (LDS_BYTES - LDSCTL_OFF) / 4; u += NWAVES * 64) ((LAS unsigned*)(lds + LDSCTL_OFF))[u] = 0u;
    __syncthreads();
#if !MK_MULTI
    (void)xcd_barrier_post((unsigned*)(ctl + CW_BAR), (volatile LAS unsigned*)(lds + LDSCTL_OFF), threadIdx.x == 0);
#define GRID_BAR() do { XcdBarrier b_; b_.bar = (unsigned*)((gu32*)(arg_ws() + WS_CTL) + CW_BAR); b_.x = xb_xcc_id(); b_.st = (volatile LAS unsigned*)(lds + LDSCTL_OFF); xcd_barrier(b_, wv == 0 && lane_id() == 0); } while (0)
#else
#define GRID_BAR() do { } while (0)
#endif
    const int lo = args.ph_lo, hi = args.ph_hi;
#ifndef SITE_MASK
#define SITE_MASK 0xFFFF
#endif
#define SITE(n) constexpr (((SITE_MASK) >> (n)) & 1)
#define IN(k) (opq_s(lo) <= (k) && (k) < opq_s(hi))
#define SEAM(k) do { if (IN(k) && IN((k) + 1)) GRID_BAR(); } while (0)
    if SITE(0) if (IN(0)) { p0_prologue(lds, vcu, G, wv); }
    SEAM(0);
    if SITE(0) if (IN(1)) { if (I8_INPROJ || I8_OUTPROJ) p1_weights_i8(lds, vcu, G, wv, true, false); }
    if (I8_INPROJ || I8_OUTPROJ) SEAM(1);
    for (int L = 0; L < 2; ++L) {
        const int pb = 2 + 11 * L;
        if SITE(1) if (IN(pb + 0)) {
#if I8_INPROJ
            pg8::DenseOrder S; S.init(arg_ws() + WS_XQ, arg_ws() + WS_WIN + (size_t)L * INC * D, NTOK, INC, D / 2, G, bx);
            pg8::EpiBf16 E{(bf16*)(arg_ws() + WS_PROJ), INC, (const float*)(arg_ws() + WS_RS), wscale(L)};
            pg8::gemm_phase<pg8::EpiBf16, pg8::DenseOrder, -1, -1, true>(lds, D / 2, S, E, wv);
#else
            pg8::DenseOrder S; S.init(arg_ws() + WS_XB, arg_ws() + WS_WIN + (size_t)L * INC * D * 2, NTOK, INC, D, G, bx);
            pg8::EpiBf16 E{(bf16*)(arg_ws() + WS_PROJ), INC, (const float*)(arg_ws() + WS_RD), 1.f};
            pg8::gemm_phase<pg8::EpiBf16, pg8::DenseOrder>(lds, D, S, E, wv);
#endif
        }
        SEAM(pb + 0);
        if SITE(2) if (IN(pb + 1)) { attn_phase(L, lds, G, wv); __syncthreads(); }
        if SITE(3) if (IN(pb + 2)) { conf_phase(L, lds, G, wv); __syncthreads(); }
        if SITE(4) if (IN(pb + 3)) { gmlp_phase(L, lds, G, wv); __syncthreads(); }
        if SITE(5) if (IN(pb + 4)) { lru_phase(L, lds, G, wv); __syncthreads(); }
        SEAM(pb + 4);
        if SITE(6) if (IN(pb + 5)) { groupnorm_phase(arg_in(20) + L * D, vcu, G, wv); if (I8_FFN1 && L == 0) { __syncthreads(); p1_weights_i8(lds, vcu, G, wv, false, true); } }
        SEAM(pb + 5);
        if (L == 0) {
            if SITE(7) if (IN(pb + 6)) {
#if I8_OUTPROJ
                pg8::DenseOrder S; S.init(arg_ws() + WS_YQ, arg_ws() + WS_WOUT, NTOK, D, D / 2, G, bx);
                pg8::EpiResB<true, true> E{arg_in(0), (bf16*)(arg_ws() + WS_XB), (const float*)(arg_ws() + WS_YS), wscale(3), nullptr};
                pg8::gemm_phase<pg8::EpiResB<true, true>, pg8::DenseOrder, -1, -1, true>(lds, D / 2, S, E, wv);
#else
                pg8::DenseOrder S; S.init(arg_ws() + WS_Y, arg_ws() + WS_WOUT, NTOK, D, D, G, bx);
                pg8::EpiResB<false, false, !I8_FFN1> E{nullptr, (bf16*)(arg_ws() + WS_XB), nullptr, 1.f, (float*)(arg_ws() + WS_SS)};
                pg8::gemm_phase<pg8::EpiResB<false, false, !I8_FFN1>, pg8::DenseOrder>(lds, D, S, E, wv);
#endif
            }
            SEAM(pb + 6);
            if SITE(8) if (IN(pb + 7)) { if (I8_FFN1) xq_phase(vcu, G, wv); else rs_phase(vcu, G, wv); }
            SEAM(pb + 7);
            if SITE(10) if (IN(pb + 8)) {
#if I8_FFN1
                pg8::DenseOrder S; S.init(arg_ws() + WS_XQ, arg_ws() + WS_WGU, NTOK, 2 * DFF, D / 2, G, bx);
#if F8_FFN2
                pg8::EpiSwiGLUF8 E{arg_ws() + WS_HID, DFF, (const float*)(arg_ws() + WS_RS), wscale(2)};
                pg8::gemm_phase<pg8::EpiSwiGLUF8, pg8::DenseOrder, -1, -1, true>(lds, D / 2, S, E, wv);
#else
                pg8::EpiSwiGLU E{(bf16*)(arg_ws() + WS_HID), DFF, (const float*)(arg_ws() + WS_RS), wscale(2)};
                pg8::gemm_phase<pg8::EpiSwiGLU, pg8::DenseOrder, -1, -1, true>(lds, D / 2, S, E, wv);
#endif
#else
                pg8::DenseOrder S; S.init(arg_ws() + WS_XB, arg_ws() + WS_WGU, NTOK, 2 * DFF, D, G, bx);
                pg8::EpiSwiGLU E{(bf16*)(arg_ws() + WS_HID), DFF, (const float*)(arg_ws() + WS_RD), 1.f};
                pg8::gemm_phase<pg8::EpiSwiGLU, pg8::DenseOrder>(lds, D, S, E, wv);
#endif
            }
            SEAM(pb + 8);
            if SITE(11) if (IN(pb + 9)) {
#if F8_FFN2
                pg8::DenseOrder S; S.init(arg_ws() + WS_HID, arg_ws() + WS_WD, NTOK, D, DFF / 2, G, bx);
                pg8::EpiResB<false, false, !I8_INPROJ> E{nullptr, (bf16*)(arg_ws() + WS_XB), nullptr, 1.f, (float*)(arg_ws() + WS_SS)};
                pg8::gemm_phase<pg8::EpiResB<false, false, !I8_INPROJ>, pg8::DenseOrder, 127 - SC_HID8, 127 - SC_WD8>(lds, DFF / 2, S, E, wv);
#else
                pg8::DenseOrder S; S.init(arg_ws() + WS_HID, arg_ws() + WS_WD, NTOK, D, DFF, G, bx);
                pg8::EpiResB<false, false, !I8_INPROJ> E{nullptr, (bf16*)(arg_ws() + WS_XB), nullptr, 1.f, (float*)(arg_ws() + WS_SS)};
                pg8::gemm_phase<pg8::EpiResB<false, false, !I8_INPROJ>, pg8::DenseOrder>(lds, DFF, S, E, wv);
#endif
            }
            SEAM(pb + 9);
            if SITE(8) if (IN(pb + 10)) { if (I8_INPROJ) xq_phase(vcu, G, wv); else rs_phase(vcu, G, wv); }
            SEAM(pb + 10);
        } else {
            if SITE(15) if (IN(pb + 6)) {
#if I8_OUTPROJ
                pg8::DenseOrder S; S.init(arg_ws() + WS_YQ, arg_ws() + WS_WOUT + (size_t)D * D, NTOK, D, D / 2, G, bx);
                pg8::EpiResB<false, true> E{nullptr, (bf16*)(arg_ws() + WS_XB), (const float*)(arg_ws() + WS_YS), wscale(4), nullptr};
                pg8::gemm_phase<pg8::EpiResB<false, true>, pg8::DenseOrder, -1, -1, true>(lds, D / 2, S, E, wv);
#else
                pg8::DenseOrder S; S.init(arg_ws() + WS_Y, arg_ws() + WS_WOUT + (size_t)D * D * 2, NTOK, D, D, G, bx);
                pg8::EpiResB<false, false> E{nullptr, (bf16*)(arg_ws() + WS_XB), nullptr, 1.f, nullptr};
                pg8::gemm_phase<pg8::EpiResB<false, false>, pg8::DenseOrder>(lds, D, S, E, wv);
#endif
            }
            SEAM(pb + 6);
            if SITE(9) if (IN(pb + 7)) norm_router_phase(arg_in(22) + D, arg_in(26), lds, G, wv);
            SEAM(pb + 7);
            if SITE(14) if (IN(pb + 8)) { moe_gather_phase(lds, vcu, G, wv); __syncthreads(); }
            SEAM(pb + 8);
#pragma clang loop unroll(disable)
            for (int st = 0; st < 3; ++st) {
                if (IN(pb + 9 + st)) {
                    moe_table(lds, wv);
                    int hv = 0;
                    if SITE(13) if (st >= 1) {
                        const int slot = st - 1;
                        pg8::MoeOrder<8> S; S.init(arg_ws() + WS_HID, arg_ws() + WS_MD8, (const LAS int*)(lds + MOE_TAB), 8 * slot, D / 256, (size_t)256 * DFE, (size_t)D * DFE, G, bx);
                        hv = (S.nM * S.nN) % G;
                        pg8::EpiMoeDown E{(const LAS int*)(lds + MOE_TAB), slot == 0};
                        pg8::gemm_phase<pg8::EpiMoeDown, pg8::MoeOrder<8>, 127 - SC_HID8, 127 - SC_WD8>(lds, DFE / 2, S, E, wv);
                    }
                    if SITE(12) if (st <= 1) {
                        pg8::MoeOrder<8> S; S.init(arg_ws() + WS_XG8, arg_ws() + WS_MGU8, (const LAS int*)(lds + MOE_TAB), 8 * st, 2 * DFE / 256, (size_t)256 * D, (size_t)2 * DFE * D, G, bx);
                        if (st == 1) { S.hv = hv; S.skip = 4; }
                        pg8::EpiSwiGLU8 E{arg_ws() + WS_HID, DFE};
                        pg8::gemm_phase<pg8::EpiSwiGLU8, pg8::MoeOrder<8>, 127 - SC_XN8, 127 - SC_WGU8>(lds, D / 2, S, E, wv);
                    }
                }
                if (st < 2) SEAM(pb + 9 + st);
            }
        }
    }
#undef IN
#undef G
#undef bx
#undef vcu
#undef SEAM
}

extern "C" void kernel_launch(void* const* d_in, const int* in_sizes, int n_in, void* d_out, int out_size, void* d_ws, size_t ws_size, hipStream_t stream) {
    static int grid = 0;
    if (grid == 0) {
        if (n_in != 30 || in_sizes[0] != NTOK * D || out_size != NTOK * D || ws_size < WS_END) { fprintf(stderr, "kernel_launch: unexpected shapes (n_in %d, ws %zu)\n", n_in, ws_size); grid = -1; return; }
        int dev = 0, cus = 0, per_cu = 0;
        if (hipGetDevice(&dev) != hipSuccess || hipDeviceGetAttribute(&cus, hipDeviceAttributeMultiprocessorCount, dev) != hipSuccess) { grid = -1; return; }
        if (hipFuncSetAttribute((const void*)fwd_kernel, hipFuncAttributeMaxDynamicSharedMemorySize, LDS_BYTES) != hipSuccess) { fprintf(stderr, "kernel_launch: hipFuncSetAttribute failed\n"); grid = -1; return; }
        if (hipOccupancyMaxActiveBlocksPerMultiprocessor(&per_cu, (const void*)fwd_kernel, NWAVES * 64, LDS_BYTES) != hipSuccess || per_cu < 1) fprintf(stderr, "kernel_launch: occupancy query reports %d\n", per_cu);
        (void)hipGetLastError();
        grid = cus;
    }
    if (grid < 0) return;
    if (hipMemsetAsync((char*)d_ws + WS_CTL, 0, CTL_ZERO_BYTES, stream) != hipSuccess) return;
    Args a{};
    for (int i = 0; i < 30; ++i) a.in[i] = (const float*)d_in[i];
    a.out = (float*)d_out; a.ws = (unsigned char*)d_ws;
#if MK_MULTI
    for (int p = 0; p < N_PHASES; ++p) for (int r = ((PROBE_MASK >> p) & 1) ? 2 : 1; r > 0; --r) { a.ph_lo = p; a.ph_hi = p + 1; hipLaunchKernelGGL(fwd_kernel, dim3(grid), dim3(NWAVES * 64), LDS_BYTES, stream, a); }
#else
    a.ph_lo = 0; a.ph_hi = N_PHASES;
    hipLaunchKernelGGL(fwd_kernel, dim3(grid), dim3(NWAVES * 64), LDS_BYTES, stream, a);
#endif
}
```

```cpp
#include <hip/hip_runtime.h>
#include <cstdio>
#include <cstdint>

#ifndef MK_MULTI
#define MK_MULTI 0
#endif
#ifndef I8_INPROJ
#define I8_INPROJ 0
#endif
static_assert(!I8_INPROJ, "the prologue no longer builds XQ / RS for an int8 in-proj");
#ifndef I8_OUTPROJ
#define I8_OUTPROJ 0
#endif
#ifndef I8_FFN1
#define I8_FFN1 1
#endif
#ifndef F8_FFN2
#define F8_FFN2 1
#endif
#ifndef PROBE_MASK
#define PROBE_MASK 0
#endif

#define GAS __attribute__((address_space(1)))
#define LAS __attribute__((address_space(3)))
typedef unsigned short bf16;
typedef short bf16x8 __attribute__((ext_vector_type(8)));
typedef float f32x4 __attribute__((ext_vector_type(4)));
typedef float f32x2 __attribute__((ext_vector_type(2)));
typedef float f32x16 __attribute__((ext_vector_type(16)));
typedef unsigned u32x4 __attribute__((ext_vector_type(4)));
typedef unsigned u32x2 __attribute__((ext_vector_type(2)));
typedef GAS unsigned gu32;

constexpr int D = 1024, BATCH = 16, SEQ = 2048, NTOK = BATCH * SEQ, INC = 2304, DFF = 2816, NE = 8, DFE = 3584;
constexpr float EPS = 1e-6f, LOG2E = 1.4426950408889634f;
constexpr int C_Q = 0, C_K = 256, C_V = 512, C_CV = 768, C_CG = 1024, C_GU = 1280, C_GV = 1536, C_LX = 1792, C_LG = 2048;

constexpr size_t MiB = 1u << 20, KiB = 1u << 10;
constexpr size_t WS_CTL = 0, CTL_ZERO_BYTES = 1 * MiB;
constexpr size_t WS_WIN = 1 * MiB;
constexpr size_t WS_WOUT = 10 * MiB;
constexpr size_t WS_WGU = 14 * MiB;
constexpr size_t WS_WD = 25 * MiB;
constexpr size_t WS_GWM = 30 * MiB + 512 * KiB;
constexpr size_t WS_WAT = WS_GWM + 262144;
constexpr size_t WS_WXT = WS_WAT + 65536;
constexpr size_t WS_MGU8 = 31 * MiB;
constexpr size_t WS_MD8 = 87 * MiB;
constexpr size_t WS_XN8 = 115 * MiB;
constexpr size_t WS_XQ = WS_XN8;
constexpr size_t WS_XG8 = 147 * MiB + 256 * KiB;
constexpr size_t WS_YQ = WS_XG8;
constexpr size_t WS_LTOK = 215 * MiB + 256 * KiB;
constexpr size_t WS_LGATE = WS_LTOK + 2 * MiB;
constexpr size_t WS_SS = WS_LGATE + 2 * MiB;
constexpr size_t WS_RS = 512 * KiB;
constexpr size_t WS_RD = 768 * KiB;
constexpr size_t WS_YS = 640 * KiB;
constexpr size_t WS_PROJ = 221 * MiB + 256 * KiB;
constexpr size_t WS_Y = WS_PROJ + 144 * MiB;
constexpr size_t WS_HID = WS_PROJ;
constexpr size_t WS_XB = WS_PROJ + 238 * MiB;
constexpr size_t WS_END = WS_XB + 64 * MiB;
constexpr int SC_XN8 = 4, SC_WGU8 = 4, SC_HID8 = 4, SC_WD8 = 4;

constexpr int CW_TMO = 0;
constexpr int CW_BAR = 4096;
constexpr int CW_MOECNT = 16384;
constexpr int CW_WMAX = 20480;

constexpr int NWAVES = 8;
constexpr int LDS_BYTES = 147456;
constexpr int LDSCTL_OFF = 146944;
constexpr int MOE_TAB = LDSCTL_OFF + 64;

#define RLX_AGENT __ATOMIC_RELAXED, __HIP_MEMORY_SCOPE_AGENT
#define LDS_WAIT() asm volatile("s_waitcnt lgkmcnt(0)" ::: "memory")
#define VM_WAIT() asm volatile("s_waitcnt vmcnt(0)" ::: "memory")
__device__ __forceinline__ int lane_id() { int l; asm volatile("v_mbcnt_lo_u32_b32 %0, -1, 0\n\tv_mbcnt_hi_u32_b32 %0, -1, %0" : "=v"(l)); return l; }
#define OPAQUE_U(x) asm volatile("" : "+s"(x))
#define OPAQUE_TID() int wave_ = wv; asm volatile("" : "+s"(wave_)); int tid = wave_ * 64 + lane_id(); asm volatile("" : "+v"(tid)); const int lane = tid & 63, wave = wave_; (void)lane; (void)wave

__device__ __forceinline__ float bf_lo(unsigned w) { return __uint_as_float(w << 16); }
__device__ __forceinline__ float bf_hi(unsigned w) { return __uint_as_float(w & 0xffff0000u); }
typedef __bf16 bf16x2_t __attribute__((ext_vector_type(2)));
__device__ __forceinline__ unsigned pk2(float lo, float hi) { f32x2 v = {lo, hi}; bf16x2_t b = __builtin_convertvector(v, bf16x2_t); return __builtin_bit_cast(unsigned, b); }
__device__ __forceinline__ unsigned pk4_fp8(float a, float b, float c, float d) {
    a = __builtin_amdgcn_fmed3f(a, -448.f, 448.f); b = __builtin_amdgcn_fmed3f(b, -448.f, 448.f); c = __builtin_amdgcn_fmed3f(c, -448.f, 448.f); d = __builtin_amdgcn_fmed3f(d, -448.f, 448.f);
    int v = 0; v = __builtin_amdgcn_cvt_pk_fp8_f32(a, b, v, false); v = __builtin_amdgcn_cvt_pk_fp8_f32(c, d, v, true); return (unsigned)v; }
template <int CTRL> __device__ __forceinline__ float dppf(float v) { return __int_as_float(__builtin_amdgcn_update_dpp(0, __float_as_int(v), CTRL, 0xf, 0xf, true)); }
template <int M> __device__ __forceinline__ float swz_xor(float v) { static_assert(M == 1 || M == 2 || M == 4 || M == 8, "M"); return dppf<M == 1 ? 0xB1 : M == 2 ? 0x4E : M == 4 ? 0x141 : 0x128>(v); }
__device__ __forceinline__ void rows16(float v, float& a, float& b) { auto r = __builtin_amdgcn_permlane16_swap(__float_as_uint(v), __float_as_uint(v), false, false); a = __uint_as_float(r[0]); b = __uint_as_float(r[1]); }
__device__ __forceinline__ float sum_rows16(float v) { float a, b; rows16(v, a, b); return a + b; }
__device__ __forceinline__ void halves(float v, float& lo, float& hi) { auto r = __builtin_amdgcn_permlane32_swap(__float_as_uint(v), __float_as_uint(v), false, false); lo = __uint_as_float(r[0]); hi = __uint_as_float(r[1]); }
__device__ __forceinline__ float sum_halves(float v) { float lo, hi; halves(v, lo, hi); return lo + hi; }
__device__ __forceinline__ unsigned pk4_i8(float a, float b, float c, float d) {
    const int q0 = __float2int_rn(a), q1 = __float2int_rn(b), q2 = __float2int_rn(c), q3 = __float2int_rn(d);
    return (unsigned)(q0 & 255) | ((unsigned)(q1 & 255) << 8) | ((unsigned)(q2 & 255) << 16) | ((unsigned)q3 << 24); }
__device__ __forceinline__ float wave_max(float v);
__device__ __forceinline__ float wave_sum(float v) {
    v += swz_xor<1>(v); v += swz_xor<2>(v); v += swz_xor<4>(v); v += swz_xor<8>(v); v = sum_rows16(v);
    return sum_halves(v);
}
__device__ __forceinline__ float one_minus_exp(float y) {
    const float ser = -y * (1.f + y * (0.5f + y * (0.16666667f + y * (0.041666668f + y * (0.008333334f + y * 0.0013888889f)))));
    const float dir = 1.f - __builtin_amdgcn_exp2f(y * LOG2E);
    return y > -0.25f ? ser : dir;
}
__device__ __forceinline__ float fast_sigmoid(float x) { return __builtin_amdgcn_rcpf(1.0f + __builtin_amdgcn_exp2f(-x * LOG2E)); }
__device__ __forceinline__ float gelu_tanh(float x) { const float u = x + 0.044715f * x * x * x; return x * __builtin_amdgcn_rcpf(1.0f + __builtin_amdgcn_exp2f(-2.0f * 0.7978845608f * LOG2E * u)); }

__device__ __forceinline__ float wave_max(float v) {
    v = fmaxf(v, swz_xor<1>(v)); v = fmaxf(v, swz_xor<2>(v)); v = fmaxf(v, swz_xor<4>(v)); v = fmaxf(v, swz_xor<8>(v)); { float a, b; rows16(v, a, b); v = fmaxf(a, b); }
    float lo, hi; halves(v, lo, hi); return fmaxf(lo, hi);
}
struct Args { const float* in[30]; float* out; unsigned char* ws; int ph_lo, ph_hi; };
typedef __attribute__((address_space(4))) const Args* KArgsPtr;
__device__ __forceinline__ KArgsPtr kargs() { KArgsPtr p = (KArgsPtr)__builtin_amdgcn_kernarg_segment_ptr(); asm volatile("" : "+s"(p)); return p; }
__device__ __forceinline__ int opq_s(int x) { asm volatile("" : "+s"(x)); return x; }
__device__ __forceinline__ const float* arg_in(int i) { return kargs()->in[i]; }
__device__ __forceinline__ float* arg_out() { return kargs()->out; }
__device__ __forceinline__ unsigned char* arg_ws() { return kargs()->ws; }

namespace pg8 {
constexpr int BM = 256, BK = 64, HALF = 128, HTB = HALF * BK * 2, STAGE_BYTES = 8 * HTB, NXCD = 8, WGM = 8;
__host__ __device__ __forceinline__ int lds_byte(int r, int c) { const int st = (r >> 4) * 2 + (c >> 5), rr = r & 15, cc = c & 31, ob = rr * 64 + cc * 2; return st * 1024 + (ob ^ (((ob >> 9) & 1) << 5)); }
__host__ __device__ __forceinline__ void stage_rc(int b, int& R, int& C) { const int st = b / 1024, sb = b % 1024, swz = sb ^ (((sb >> 9) & 1) << 5); R = (st >> 1) * 16 + swz / 64; C = (st & 1) * 32 + (swz % 64) / 2; }
__host__ __device__ __forceinline__ int perm32(int rho) { const int n = rho >> 4, i = rho & 15; return 8 * (i >> 2) + 4 * n + (i & 3); }

struct Unit { int pm, pn, e, mt, se; };

__device__ __forceinline__ bool static_unit_L(long L, int nM, int nN, int& pm, int& pn) {
    const int nwg = nM * nN; if (L >= nwg) return false;
    int wgid = (int)L; { const int q = nwg / NXCD, r = nwg % NXCD, xcd = wgid % NXCD, off = wgid / NXCD; wgid = (xcd < r ? xcd * (q + 1) : r * (q + 1) + (xcd - r) * q) + off; }
    const int nig = WGM * nN, gid = wgid / nig, fm = gid * WGM, gsz = (nM - fm) < WGM ? (nM - fm) : WGM;
    pm = fm + ((wgid % nig) % gsz); pn = (wgid % nig) / gsz; return true;
}
__device__ __forceinline__ bool static_unit(int i, int G, int c, int nM, int nN, int& pm, int& pn) { return static_unit_L((long)i * G + c, nM, nN, pm, pn); }
struct DenseOrder {
    static constexpr bool GATHER = false;
    const char* A; const char* B; int nM, nN, G, c; unsigned tstep;
    __device__ __forceinline__ void init(const void* A_, const void* B_, int M, int N, int K, int G_, int c_) { A = (const char*)A_; B = (const char*)B_; nM = M / BM; nN = N / BM; G = G_; c = c_; tstep = (unsigned)BM * K * 2; }
    __device__ __forceinline__ bool next(int i, Unit& u) const { u.e = 0; u.mt = 0; u.se = 0; return static_unit(i, G, c, nM, nN, u.pm, u.pn); }
    __device__ __forceinline__ unsigned aoff(const Unit& u) const { return (unsigned)u.pm * (unsigned)tstep; }
    __device__ __forceinline__ unsigned boff(const Unit& u) const { return (unsigned)u.pn * (unsigned)tstep; }
    __device__ __forceinline__ void rows(const Unit&, int, int, unsigned (&)[2][2]) const {}
};
template <int NSE> struct MoeOrder {
    static constexpr bool GATHER = false;
    const char* A; const char* B; const LAS int* tab; int se0, pm0, nM, nN, G, c; unsigned tstep, bstride;
    int hv = 0, skip = 0;
    __device__ __forceinline__ void init(const void* A_, const void* B_, const LAS int* tab_, int se0_, int nN_, unsigned tstep_, unsigned bstride_, int G_, int c_) {
        A = (const char*)A_; B = (const char*)B_; tab = tab_; se0 = se0_; pm0 = __builtin_amdgcn_readfirstlane(tab_[16 + se0_]); nM = __builtin_amdgcn_readfirstlane(tab_[16 + se0_ + NSE]) - pm0;
        nN = nN_; tstep = tstep_; bstride = bstride_; G = G_; c = c_; }
    __device__ __forceinline__ bool next(int i, Unit& u) const {
        const int Gl = G - hv; long L;
        if (c >= hv) L = i < skip ? (long)i * Gl + (c - hv) : (long)skip * Gl + (long)(i - skip) * G + c; else L = (long)skip * Gl + (long)i * G + c;
        int pl; if (!static_unit_L(L, nM, nN, pl, u.pn)) return false;
        const int pm = pm0 + pl; int se = se0;
#pragma unroll
        for (int j = 1; j < NSE; ++j) se += (pm >= tab[16 + se0 + j]) ? 1 : 0;
        se = __builtin_amdgcn_readfirstlane(se);
        u.pm = pm; u.se = se; u.e = se & 7; u.mt = __builtin_amdgcn_readfirstlane(pm - tab[16 + se]); return true;
    }
    __device__ __forceinline__ unsigned aoff(const Unit& u) const { return (unsigned)u.pm * (unsigned)tstep; }
    __device__ __forceinline__ unsigned boff(const Unit& u) const { return (unsigned)u.e * (unsigned)bstride + (unsigned)u.pn * (unsigned)tstep; }
    __device__ __forceinline__ void rows(const Unit&, int, int, unsigned (&)[2][2]) const {}
};

struct EpiBf16 {
    static constexpr bool PERM = true; static constexpr int NPRE = 8;
    bf16* O; int ldc; const float* rs; float wsc;
    __device__ __forceinline__ void preload(float (&pre)[8], const Unit& u, int wr, int fr) const {
#pragma unroll
        for (int i = 0; i < 8; ++i) pre[i] = rs[u.pm * BM + wr * 64 + fr + (i >> 2) * HALF + (i & 3) * 16];
    }
    __device__ __forceinline__ void operator()(const f32x4 (&acc)[2][2][4][2], const Unit& u, int wr, int wc, int fr, int fq, const float (&rsv)[8]) const {
        const int row0 = u.pm * BM + wr * 64 + fr, col0 = u.pn * BM + wc * 32 + 8 * fq;
#pragma unroll
        for (int ai = 0; ai < 2; ++ai)
#pragma unroll
            for (int m = 0; m < 4; ++m) { const int r = row0 + ai * HALF + m * 16; bf16* rowp = O + (size_t)r * ldc + col0; const float rs = rsv[ai * 4 + m] * wsc;
#pragma unroll
                for (int bj = 0; bj < 2; ++bj) { const f32x4 v0 = acc[ai][bj][m][0] * rs, v1 = acc[ai][bj][m][1] * rs;
                    u32x4 w; w.x = pk2(v0[0], v0[1]); w.y = pk2(v0[2], v0[3]); w.z = pk2(v1[0], v1[1]); w.w = pk2(v1[2], v1[3]);
                    *(u32x4*)(rowp + bj * HALF) = w; } }
    }
};
template <bool RF32, bool SCALED, bool SSOUT = false> struct EpiResB {
    static constexpr int NPRE = SCALED ? 8 : 0; static constexpr bool PERM = true;
    const float* R; bf16* XB; const float* ys; float wsc; float* SS;
    __device__ __forceinline__ void preload(float (&pre)[8], const Unit& u, int wr, int fr) const {
#pragma unroll
        for (int i = 0; i < 8; ++i) pre[i] = ys[u.pm * BM + wr * 64 + fr + (i >> 2) * HALF + (i & 3) * 16];
    }
    __device__ __forceinline__ void operator()(const f32x4 (&acc)[2][2][4][2], const Unit& u, int wr, int wc, int fr, int fq, const float (&pre)[8]) const { run(acc, u, wr, wc, fr, fq, pre); }
    __device__ __forceinline__ void operator()(const f32x4 (&acc)[2][2][4][2], const Unit& u, int wr, int wc, int fr, int fq) const { const float one[8] = {1.f, 1.f, 1.f, 1.f, 1.f, 1.f, 1.f, 1.f}; run(acc, u, wr, wc, fr, fq, one); }
    __device__ __forceinline__ void run(const f32x4 (&acc)[2][2][4][2], const Unit& u, int wr, int wc, int fr, int fq, const float (&pre)[8]) const {
        const int row0 = u.pm * BM + wr * 64 + fr, col0 = u.pn * BM + wc * 32 + 8 * fq;
#pragma unroll
        for (int aj = 0; aj < 4; ++aj) { const int ai = aj >> 1, m0 = 2 * (aj & 1); constexpr int MG = 2;
            f32x4 xr[4][2][2]; u32x4 xb_[4][2];
#pragma unroll
            for (int m = m0; m < m0 + MG; ++m) { const size_t ro = (size_t)(row0 + ai * HALF + m * 16) * D + col0;
#pragma unroll
                for (int bj = 0; bj < 2; ++bj) {
                    if constexpr (RF32) { xr[m][bj][0] = *(const f32x4*)(R + ro + bj * HALF); xr[m][bj][1] = *(const f32x4*)(R + ro + bj * HALF + 4); }
                    else xb_[m][bj] = *(const u32x4*)(XB + ro + bj * HALF); } }
            asm volatile("" ::: "memory");
#pragma unroll
            for (int m = m0; m < m0 + MG; ++m) { const int r = row0 + ai * HALF + m * 16; const size_t ro = (size_t)r * D + col0; const float f = SCALED ? pre[ai * 4 + m] * wsc : 1.f;
                f32x4 xv[2][2];
#pragma unroll
                for (int bj = 0; bj < 2; ++bj) {
                    if constexpr (RF32) { xv[bj][0] = xr[m][bj][0]; xv[bj][1] = xr[m][bj][1]; }
                    else { const u32x4 b = xb_[m][bj]; xv[bj][0] = (f32x4){bf_lo(b.x), bf_hi(b.x), bf_lo(b.y), bf_hi(b.y)}; xv[bj][1] = (f32x4){bf_lo(b.z), bf_hi(b.z), bf_lo(b.w), bf_hi(b.w)}; } }
                float sq = 0.f;
#pragma unroll
                for (int bj = 0; bj < 2; ++bj) { const f32x4 x0 = xv[bj][0] + acc[ai][bj][m][0] * f, x1 = xv[bj][1] + acc[ai][bj][m][1] * f;
                    if constexpr (SSOUT) sq += ((x0.x * x0.x + x0.y * x0.y) + (x0.z * x0.z + x0.w * x0.w)) + ((x1.x * x1.x + x1.y * x1.y) + (x1.z * x1.z + x1.w * x1.w));
                    u32x4 o; o.x = pk2(x0.x, x0.y); o.y = pk2(x0.z, x0.w); o.z = pk2(x1.x, x1.y); o.w = pk2(x1.z, x1.w); *(u32x4*)(XB + ro + bj * HALF) = o; }
                if constexpr (SSOUT) { sq = sum_rows16(sq); sq = sum_halves(sq); if (fq == 0) SS[(size_t)r * 16 + 4 * u.pn + wc] = sq; } }
        }
    }
};
__device__ __forceinline__ float silu_mul(float g, float u) { return g * __builtin_amdgcn_rcpf(1.0f + __builtin_amdgcn_exp2f(-g * LOG2E)) * u; }
struct EpiSwiGLU {
    static constexpr bool PERM = true; static constexpr int NPRE = 8;
    bf16* H; int ldh; const float* rs; float wsc;
    __device__ __forceinline__ void preload(float (&pre)[8], const Unit& u, int wr, int fr) const {
#pragma unroll
        for (int i = 0; i < 8; ++i) pre[i] = rs[u.pm * BM + wr * 64 + fr + (i >> 2) * HALF + (i & 3) * 16];
    }
    __device__ __forceinline__ void operator()(const f32x4 (&acc)[2][2][4][2], const Unit& u, int wr, int wc, int fr, int fq, const float (&rsv)[8]) const {
        const int row0 = u.pm * BM + wr * 64 + fr, col0 = u.pn * HALF + wc * 32 + 8 * fq;
#pragma unroll
        for (int ai = 0; ai < 2; ++ai)
#pragma unroll
            for (int m = 0; m < 4; ++m) { const int r = row0 + ai * HALF + m * 16; bf16* rowp = H + (size_t)r * ldh + col0; const float rs = rsv[ai * 4 + m] * wsc;
                const f32x4 g0 = acc[ai][0][m][0] * rs, g1 = acc[ai][0][m][1] * rs, u0 = acc[ai][1][m][0] * rs, u1 = acc[ai][1][m][1] * rs;
                u32x4 w; w.x = pk2(silu_mul(g0[0], u0[0]), silu_mul(g0[1], u0[1])); w.y = pk2(silu_mul(g0[2], u0[2]), silu_mul(g0[3], u0[3]));
                w.z = pk2(silu_mul(g1[0], u1[0]), silu_mul(g1[1], u1[1])); w.w = pk2(silu_mul(g1[2], u1[2]), silu_mul(g1[3], u1[3]));
                *(u32x4*)rowp = w; }
    }
};
struct EpiSwiGLUF8 {
    static constexpr bool PERM = true; static constexpr int NPRE = 8;
    unsigned char* H; int ldh; const float* rs; float wsc;
    __device__ __forceinline__ void preload(float (&pre)[8], const Unit& u, int wr, int fr) const {
#pragma unroll
        for (int i = 0; i < 8; ++i) pre[i] = rs[u.pm * BM + wr * 64 + fr + (i >> 2) * HALF + (i & 3) * 16];
    }
    __device__ __forceinline__ void operator()(const f32x4 (&acc)[2][2][4][2], const Unit& u, int wr, int wc, int fr, int fq, const float (&rsv)[8]) const {
        const int row0 = u.pm * BM + wr * 64 + fr, col0 = u.pn * HALF + wc * 32 + 8 * fq; const float sc = (float)(1 << SC_HID8);
#pragma unroll
        for (int ai = 0; ai < 2; ++ai)
#pragma unroll
            for (int m = 0; m < 4; ++m) { unsigned char* rowp = H + (size_t)(row0 + ai * HALF + m * 16) * ldh + col0; const float f = rsv[ai * 4 + m] * wsc;
                const f32x4 g0 = acc[ai][0][m][0] * f, g1 = acc[ai][0][m][1] * f, u0 = acc[ai][1][m][0] * f, u1 = acc[ai][1][m][1] * f;
                u32x2 w; w.x = pk4_fp8(sc * silu_mul(g0[0], u0[0]), sc * silu_mul(g0[1], u0[1]), sc * silu_mul(g0[2], u0[2]), sc * silu_mul(g0[3], u0[3]));
                w.y = pk4_fp8(sc * silu_mul(g1[0], u1[0]), sc * silu_mul(g1[1], u1[1]), sc * silu_mul(g1[2], u1[2]), sc * silu_mul(g1[3], u1[3]));
                *(u32x2*)rowp = w; }
    }
};
struct EpiSwiGLU8 {
    static constexpr bool PERM = false; static constexpr int NPRE = 0;
    unsigned char* H; int ldh;
    __device__ __forceinline__ void operator()(const f32x4 (&acc)[2][2][4][2], const Unit& u, int wr, int wc, int fr, int fq) const {
        const int row0 = u.pm * BM + wr * 64 + fr, col0 = u.pn * HALF + wc * 32 + 4 * fq; const float sc = (float)(1 << SC_HID8);
#pragma unroll
        for (int ai = 0; ai < 2; ++ai)
#pragma unroll
            for (int m = 0; m < 4; ++m) { unsigned char* rowp = H + (size_t)(row0 + ai * HALF + m * 16) * ldh + col0;
#pragma unroll
                for (int n = 0; n < 2; ++n) { const f32x4 g = acc[ai][0][m][n], up = acc[ai][1][m][n];
                    *(unsigned*)(rowp + 16 * n) = pk4_fp8(sc * silu_mul(g[0], up[0]), sc * silu_mul(g[1], up[1]), sc * silu_mul(g[2], up[2]), sc * silu_mul(g[3], up[3])); } }
    }
};
struct EpiMoeDown {
    static constexpr bool PERM = false; static constexpr int NPRE = 0;
    const LAS int* tab; int first;
    __device__ __forceinline__ void operator()(const f32x4 (&acc)[2][2][4][2], const Unit& u, int wr, int wc, int fr, int fq) const {
        float* C = arg_out(); const int cnt = tab[u.se]; const int* lt = (const int*)(arg_ws() + WS_LTOK) + (size_t)u.se * NTOK; const float* lg = (const float*)(arg_ws() + WS_LGATE) + (size_t)u.se * NTOK;
        const int p0 = u.mt * 256 + wr * 64 + fr, col0 = u.pn * BM + wc * 32 + 4 * fq;
#pragma unroll
        for (int ai = 0; ai < 2; ++ai)
#pragma unroll
            for (int m = 0; m < 4; ++m) { const int p = p0 + ai * HALF + m * 16;
                if (p < cnt) { const int tok = lt[p]; const float g = lg[p]; float* rowp = C + (size_t)tok * D + col0; bf16* xrow = (bf16*)(arg_ws() + WS_XB) + (size_t)tok * D + col0;
                    f32x4 rv[2][2];
#pragma unroll
                    for (int bj = 0; bj < 2; ++bj)
#pragma unroll
                        for (int n = 0; n < 2; ++n) { const u32x2 b = *(const u32x2*)(xrow + bj * HALF + n * 16); rv[bj][n] = (f32x4){bf_lo(b.x), bf_hi(b.x), bf_lo(b.y), bf_hi(b.y)}; }
#pragma unroll
                    for (int bj = 0; bj < 2; ++bj)
#pragma unroll
                        for (int n = 0; n < 2; ++n) { const f32x4 x = rv[bj][n] + g * acc[ai][bj][m][n];
                            if (first) { u32x2 o; o.x = pk2(x.x, x.y); o.y = pk2(x.z, x.w); *(u32x2*)(xrow + bj * HALF + n * 16) = o; }
                            else *(f32x4*)(rowp + bj * HALF + n * 16) = x; } } }
    }
};

typedef int v8i_t __attribute__((ext_vector_type(8)));
typedef int v4i_t __attribute__((ext_vector_type(4)));
__device__ __forceinline__ v8i_t cat8(bf16x8 a, bf16x8 b) { return __builtin_shufflevector(__builtin_bit_cast(v4i_t, a), __builtin_bit_cast(v4i_t, b), 0, 1, 2, 3, 4, 5, 6, 7); }
template <class Epi, class Sched, int SA = -1, int SB = -1, bool I8 = false>
__device__ __forceinline__ void gemm_phase(LAS unsigned char* lds, const int K, const Sched& S, const Epi& E, const int wv) {
    int wid_ = wv; asm volatile("" : "+s"(wid_));
    int tid_ = wid_ * 64 + lane_id(); asm volatile("" : "+v"(tid_));
    const int tid = tid_, wid = wid_, lane = tid & 63, wr = wid >> 2, wc = wid & 3, fr = lane & 15, fq = lane >> 4;
    const int nt = K / BK;
    unsigned voffB[2];
    unsigned offAc[2][2];
    LAS u32x4* stash = (LAS u32x4*)(lds + STAGE_BYTES) + tid;
    const unsigned kstep = (unsigned)(BK * 2);
    const unsigned hstep = (unsigned)HALF * (unsigned)K * 2u;
#pragma unroll
    for (int i = 0; i < 2; ++i) { int R, C; stage_rc(tid * 16 + i * 8192, R, C); const int Rb = Epi::PERM ? ((R & ~31) + perm32(R & 31)) : R;
        voffB[i] = (unsigned)(Rb * K + C) * 2u;
        offAc[0][i] = (unsigned)(R * K + C) * 2u; offAc[1][i] = offAc[0][i] + hstep; }
    const __amdgpu_buffer_rsrc_t rA = __builtin_amdgcn_make_buffer_rsrc((void*)S.A, 0, 0x7ffffff0, 0x00020000);
    const __amdgpu_buffer_rsrc_t rB = __builtin_amdgcn_make_buffer_rsrc((void*)S.B, 0, 0x7ffffff0, 0x00020000);
    const unsigned ldsw = (unsigned)wid * 1024u;
    const int aoff = lds_byte(wr * 64 + fr, fq * 8), boff = lds_byte(wc * 32 + fr, fq * 8);
#define PG8_SA(b, h) (((b) * 2 + (h)) * HTB)
#define PG8_SB(b, h) ((4 + (b) * 2 + (h)) * HTB)
#define PG8_STAGE_R(bufoff, rs, soff, voff) do { _Pragma("unroll") for (int _i = 0; _i < 2; ++_i) \
        __builtin_amdgcn_raw_ptr_buffer_load_lds(rs, (LAS unsigned*)(lds + (bufoff) + ldsw + _i * 8192), 16, (voff)[_i], (soff), 0, 0); } while (0)
#define PG8_STAGE_A(bufoff, soff, voff) PG8_STAGE_R(bufoff, rA, soff, voff)
#define PG8_STAGE_A1(bufoff, soff) do { if constexpr (Sched::GATHER) PG8_STAGE_R(bufoff, rA, soff, offAc[1]); else PG8_STAGE_R(bufoff, rA, (soff) + hstep, offAc[0]); } while (0)
#define PG8_STAGE_B(bufoff, soff, voff) PG8_STAGE_R(bufoff, rB, soff, voff)
#define PG8_LDA(dst, b, h) do { _Pragma("unroll") for (int m = 0; m < 4; ++m) _Pragma("unroll") for (int k = 0; k < 2; ++k) dst[m][k] = *(const LAS bf16x8*)(lds + PG8_SA(b, h) + aoff + m * 2048 + k * 1024); } while (0)
#define PG8_LDB(dst, b, h) do { _Pragma("unroll") for (int n = 0; n < 2; ++n) _Pragma("unroll") for (int k = 0; k < 2; ++k) dst[n][k] = *(const LAS bf16x8*)(lds + PG8_SB(b, h) + boff + n * 2048 + k * 1024); } while (0)
#define PG8_MMA(ai, bj, At, Bt) do { __builtin_amdgcn_s_setprio(1); _Pragma("unroll") for (int m = 0; m < 4; ++m) _Pragma("unroll") for (int n = 0; n < 2; ++n) { \
        if constexpr (SA >= 0) acc[ai][bj][m][n] = __builtin_amdgcn_mfma_scale_f32_16x16x128_f8f6f4(cat8(Bt[n][0], Bt[n][1]), cat8(At[m][0], At[m][1]), acc[ai][bj][m][n], 0, 0, 0, scl_b, 0, scl_a); \
        else if constexpr (I8) { _Pragma("unroll") for (int k = 0; k < 2; ++k) acc[ai][bj][m][n] = __builtin_bit_cast(f32x4, __builtin_amdgcn_mfma_i32_16x16x64_i8(__builtin_bit_cast(v4i_t, Bt[n][k]), __builtin_bit_cast(v4i_t, At[m][k]), __builtin_bit_cast(v4i_t, acc[ai][bj][m][n]), 0, 0, 0)); } \
        else { _Pragma("unroll") for (int k = 0; k < 2; ++k) acc[ai][bj][m][n] = __builtin_amdgcn_mfma_f32_16x16x32_bf16(Bt[n][k], At[m][k], acc[ai][bj][m][n], 0, 0, 0); } } \
        __builtin_amdgcn_s_setprio(0); } while (0)
#define PG8_WAIT_V(n) asm volatile("s_waitcnt vmcnt(" #n ")" ::: "memory")
#define PG8_WAIT_L(n) asm volatile("s_waitcnt lgkmcnt(" #n ")" ::: "memory")
#define PG8_BAR __builtin_amdgcn_s_barrier()
#define PG8_SCHED __builtin_amdgcn_sched_barrier(0)
    int scl_a = SA * 0x01010101; asm volatile("" : "+v"(scl_a));
    const int scl_b = (SA == SB) ? scl_a : SB * 0x01010101;
    Unit cur, nxt; int ui = 0;
    if (!S.next(0, cur)) return;
    f32x4 acc[2][2][4][2];
#pragma unroll
    for (int a = 0; a < 2; ++a)
#pragma unroll
        for (int b = 0; b < 2; ++b)
#pragma unroll
            for (int m = 0; m < 4; ++m)
#pragma unroll
                for (int n = 0; n < 2; ++n) acc[a][b][m][n] = (f32x4){0.f, 0.f, 0.f, 0.f};
    bf16x8 At[4][2], B0[2][2], B1[2][2];
    unsigned cA = S.aoff(cur), cB = S.boff(cur);
    if constexpr (Sched::GATHER) S.rows(cur, tid, K, offAc);
    PG8_STAGE_B(PG8_SB(0, 0), cB, voffB); PG8_STAGE_B(PG8_SB(0, 1), cB + hstep, voffB); PG8_STAGE_A(PG8_SA(0, 0), cA, offAc[0]); PG8_STAGE_A1(PG8_SA(0, 1), cA);
    if (wr == 1) PG8_BAR;
    PG8_WAIT_V(2); PG8_BAR;
    PG8_STAGE_B(PG8_SB(1, 0), cB + kstep, voffB); PG8_STAGE_A(PG8_SA(1, 0), cA + kstep, offAc[0]); PG8_STAGE_B(PG8_SB(1, 1), cB + hstep + kstep, voffB);
    PG8_WAIT_V(6); PG8_BAR;
    for (;;) {
        const bool has_next = S.next(ui + 1, nxt);
        const unsigned nA = has_next ? S.aoff(nxt) : cA, nB = has_next ? S.boff(nxt) : cB;
        float epre[Epi::NPRE ? Epi::NPRE : 1];
        if constexpr (Epi::NPRE > 0) { int l1 = lane_id(); asm volatile("" : "+v"(l1)); E.preload(epre, cur, wr, l1 & 15); }
        if constexpr (Sched::GATHER) { unsigned offAn[2][2];
            if (has_next) S.rows(nxt, tid, K, offAn);
            else {
#pragma unroll
                for (int h = 0; h < 2; ++h) { offAn[h][0] = offAc[h][0]; offAn[h][1] = offAc[h][1]; } }
            *stash = (u32x4){offAn[0][0], offAn[0][1], offAn[1][0], offAn[1][1]}; }
#pragma clang loop unroll(disable)
        for (int t = 0; t < nt; t += 2) {
            const bool last = (t == nt - 2);
            const unsigned a1 = cA + (unsigned)(t + 1) * kstep;
            const unsigned a2 = last ? nA : cA + (unsigned)(t + 2) * kstep, b2 = last ? nB : cB + (unsigned)(t + 2) * kstep;
            const unsigned a3 = a2 + kstep, b3 = b2 + kstep;
            PG8_LDB(B0, 0, 0); PG8_LDB(B1, 0, 1); PG8_SCHED; PG8_LDA(At, 0, 0); PG8_STAGE_A1(PG8_SA(1, 1), a1);
            if constexpr (Sched::GATHER) {
                const unsigned lm = last ? 0xffffffffu : 0u; const u32x4 nx = *stash;
                offAc[0][0] = (offAc[0][0] & ~lm) | (nx.x & lm); offAc[0][1] = (offAc[0][1] & ~lm) | (nx.y & lm); offAc[1][0] = (offAc[1][0] & ~lm) | (nx.z & lm); offAc[1][1] = (offAc[1][1] & ~lm) | (nx.w & lm); }
            PG8_WAIT_V(8); PG8_WAIT_L(0); PG8_BAR; PG8_MMA(0, 0, At, B0); PG8_MMA(0, 1, At, B1); PG8_BAR; PG8_SCHED;
            PG8_LDA(At, 0, 1); PG8_STAGE_B(PG8_SB(0, 0), b2, voffB); PG8_STAGE_B(PG8_SB(0, 1), b2 + hstep, voffB); PG8_STAGE_A(PG8_SA(0, 0), a2, offAc[0]);
            PG8_WAIT_V(8); PG8_WAIT_L(0); PG8_BAR; PG8_MMA(1, 0, At, B0); PG8_MMA(1, 1, At, B1); PG8_BAR; PG8_SCHED;
            PG8_LDB(B0, 1, 0); PG8_LDB(B1, 1, 1); PG8_SCHED; PG8_LDA(At, 1, 0); PG8_STAGE_A1(PG8_SA(0, 1), a2);
            PG8_WAIT_V(8); PG8_WAIT_L(0); PG8_BAR; PG8_MMA(0, 0, At, B0); PG8_MMA(0, 1, At, B1); PG8_BAR; PG8_SCHED;
            PG8_LDA(At, 1, 1); PG8_STAGE_B(PG8_SB(1, 0), b3, voffB); PG8_STAGE_B(PG8_SB(1, 1), b3 + hstep, voffB); PG8_STAGE_A(PG8_SA(1, 0), a3, offAc[0]);
            PG8_WAIT_V(8); PG8_WAIT_L(0); PG8_BAR; PG8_MMA(1, 0, At, B0); PG8_MMA(1, 1, At, B1); PG8_BAR; PG8_SCHED;
        }
        if (wr == 0) PG8_BAR;
        PG8_SCHED;
        if constexpr (I8) {
#pragma unroll
            for (int a = 0; a < 2; ++a)
#pragma unroll
                for (int b = 0; b < 2; ++b)
#pragma unroll
                    for (int m = 0; m < 4; ++m)
#pragma unroll
                        for (int n = 0; n < 2; ++n) { const v4i_t q = __builtin_bit_cast(v4i_t, acc[a][b][m][n]); acc[a][b][m][n] = (f32x4){(float)q.x, (float)q.y, (float)q.z, (float)q.w}; } }
        { int l2 = lane_id(); asm volatile("" : "+v"(l2)); if constexpr (Epi::NPRE > 0) E(acc, cur, wr, wc, l2 & 15, l2 >> 4, epre); else E(acc, cur, wr, wc, l2 & 15, l2 >> 4); }
        PG8_SCHED;
        if (!has_next) break;
#pragma unroll
        for (int a = 0; a < 2; ++a)
#pragma unroll
            for (int b = 0; b < 2; ++b)
#pragma unroll
                for (int m = 0; m < 4; ++m)
#pragma unroll
                    for (int n = 0; n < 2; ++n) acc[a][b][m][n] = (f32x4){0.f, 0.f, 0.f, 0.f};
        PG8_SCHED;
        cur = nxt; cA = nA; cB = nB; ++ui;
        if (wr == 1) PG8_BAR;
    }
    PG8_WAIT_V(0);
    PG8_BAR;
#undef PG8_SA
#undef PG8_SB
#undef PG8_STAGE_R
#undef PG8_STAGE_A
#undef PG8_STAGE_A1
#undef PG8_STAGE_B
#undef PG8_LDA
#undef PG8_LDB
#undef PG8_MMA
#undef PG8_WAIT_V
#undef PG8_WAIT_L
#undef PG8_BAR
#undef PG8_SCHED
}
}

#define XB_TMO      128
#define XB_XCNT(j)  (256  + 64 * (j))
#define XB_XSUB(j)  (1280 + 64 * (j))
#define XB_XGEN(j)  (2304 + 64 * (j))
#define XB_TOP      3328
#define XB_TOPGEN   3392
#define XCD_BAR_WORDS 3456
#define XB_SPIN_CAP (1u << 18)
__device__ __forceinline__ unsigned long long xb_z() { unsigned long long z; asm volatile("v_mov_b64 %0, 0" : "=v"(z)); return z; }
__device__ __forceinline__ unsigned xb_ld(unsigned* p)              { return __hip_atomic_load(p + xb_z(), __ATOMIC_RELAXED, __HIP_MEMORY_SCOPE_AGENT); }
__device__ __forceinline__ unsigned xb_add(unsigned* p, unsigned v) { return __hip_atomic_fetch_add(p + xb_z(), v, __ATOMIC_RELAXED, __HIP_MEMORY_SCOPE_AGENT); }
__device__ __forceinline__ unsigned xb_xcc_id() { return (unsigned)__builtin_amdgcn_s_getreg((3 << 11) | 20) & 0xFu; }
#define XB_SPIN(cond, bar) do { unsigned _sp = 0; while (cond) { __builtin_amdgcn_s_sleep(1); \
    if ((++_sp & 255u) == 0u) { if (xb_ld(&(bar)[XB_TMO])) break; if (_sp > XB_SPIN_CAP) { (void)xb_add(&(bar)[XB_TMO], 1u); break; } } } } while (0)
struct XcdBarrier { unsigned* bar; unsigned x; volatile LAS unsigned* st; };
__device__ __forceinline__ XcdBarrier xcd_barrier_post(unsigned* bar, volatile LAS unsigned* st, bool t0) {
    XcdBarrier b; b.bar = bar; b.x = xb_xcc_id(); b.st = st;
    if (t0) (void)xb_add(&bar[XB_XCNT(b.x)], 1u);
    return b;
}
__device__ __forceinline__ void xcd_barrier_complete(unsigned* bar, unsigned x, unsigned& nloc, unsigned& nx) {
    const unsigned G = gridDim.x * gridDim.y * gridDim.z;
    unsigned sum, cnt, mine, sp = 0u;
    for (;;) {
        sum = 0u; cnt = 0u; mine = 0u;
#pragma unroll
        for (unsigned j = 0; j < 16; ++j) { const unsigned c = xb_ld(&bar[XB_XCNT(j)]); sum += c; cnt += (c > 0u) ? 1u : 0u; mine = (j == x) ? c : mine; }
        if (sum == G) break;
        __builtin_amdgcn_s_sleep(1);
        if ((++sp & 255u) == 0u) { if (xb_ld(&bar[XB_TMO])) break; if (sp > XB_SPIN_CAP) { (void)xb_add(&bar[XB_TMO], 1u); break; } }
    }
    nloc = mine > 0u ? mine : 1u; nx = cnt > 0u ? cnt : 1u;
}
__device__ __forceinline__ void xcd_barrier(const XcdBarrier& b, bool t0) {
    asm volatile("s_waitcnt vmcnt(0)" ::: "memory");
    __syncthreads();
    if (t0) {
        unsigned* bar = b.bar;
        __builtin_amdgcn_s_waitcnt(0);
        unsigned nloc = b.st[0], nx = b.st[1];
        if (nloc == 0u) { xcd_barrier_complete(bar, b.x, nloc, nx); b.st[0] = nloc; b.st[1] = nx; }
        const unsigned old = xb_add(&bar[XB_XSUB(b.x)], 1u);
        const unsigned gen = old / nloc;
        if (old + 1u == (gen + 1u) * nloc) {
            __builtin_amdgcn_fence(__ATOMIC_RELEASE, "agent");
            asm volatile("s_waitcnt vmcnt(0)" ::: "memory");
            const unsigned og = xb_add(&bar[XB_TOP], 1u);
            const unsigned tg = og / nx;
            if (og + 1u == (tg + 1u) * nx) xb_add(&bar[XB_TOPGEN], 1u);
            else XB_SPIN(xb_ld(&bar[XB_TOPGEN]) == tg, bar);
            __builtin_amdgcn_fence(__ATOMIC_ACQUIRE, "agent");
            xb_add(&bar[XB_XGEN(b.x)], 1u);
            asm volatile("s_waitcnt vmcnt(0)" ::: "memory");
        } else {
            XB_SPIN(xb_ld(&bar[XB_XGEN(b.x)]) == gen, bar);
            __builtin_amdgcn_fence(__ATOMIC_ACQUIRE, "agent");
            asm volatile("s_waitcnt vmcnt(0)" ::: "memory");
        }
    }
    __syncthreads();
}

__device__ __forceinline__ void transpose_item(const float* W, int N, int K, bf16* WT, int k0, int n0, int drow0, const float* gk, LAS float* scr, int lane) {
    { const int kr = lane >> 3, q4 = 4 * (lane & 7); f32x4 v[8]; float g[8];
#pragma unroll
      for (int i = 0; i < 8; ++i) { v[i] = *(const f32x4*)(W + (size_t)(k0 + 8 * i + kr) * N + n0 + q4); g[i] = gk ? gk[k0 + 8 * i + kr] : 1.f; }
#pragma unroll
      for (int i = 0; i < 8; ++i) { LAS float* d = scr + (8 * i + kr) * 33 + q4; d[0] = v[i].x * g[i]; d[1] = v[i].y * g[i]; d[2] = v[i].z * g[i]; d[3] = v[i].w * g[i]; } }
    LDS_WAIT(); asm volatile("" ::: "memory");
    const int c = lane & 7;
#pragma unroll
    for (int j = 0; j < 4; ++j) { const int n = (lane >> 3) + 8 * j; const LAS float* s = scr + (8 * c) * 33 + n;
        u32x4 o; o.x = pk2(s[0 * 33], s[1 * 33]); o.y = pk2(s[2 * 33], s[3 * 33]); o.z = pk2(s[4 * 33], s[5 * 33]); o.w = pk2(s[6 * 33], s[7 * 33]);
        *(u32x4*)(WT + (size_t)(drow0 + n) * K + k0 + 8 * c) = o; }
    LDS_WAIT(); asm volatile("" ::: "memory");
}
__device__ __forceinline__ void transpose_item8(const float* W, int N, int K, unsigned char* WT, int k0, int n0, int drow0, float sc, LAS float* scr, int lane) {
    { const int kr = lane >> 3, q4 = 4 * (lane & 7); f32x4 v[16];
#pragma unroll
      for (int i = 0; i < 16; ++i) v[i] = *(const f32x4*)(W + (size_t)(k0 + 8 * i + kr) * N + n0 + q4);
#pragma unroll
      for (int i = 0; i < 16; ++i) { LAS float* d = scr + (8 * i + kr) * 33 + q4; d[0] = v[i].x; d[1] = v[i].y; d[2] = v[i].z; d[3] = v[i].w; } }
    LDS_WAIT(); asm volatile("" ::: "memory");
    const int c = lane & 7;
#pragma unroll
    for (int j = 0; j < 4; ++j) { const int n = (lane >> 3) + 8 * j; const LAS float* s = scr + (16 * c) * 33 + n;
        u32x4 o; o.x = pk4_fp8(sc * s[0 * 33], sc * s[1 * 33], sc * s[2 * 33], sc * s[3 * 33]); o.y = pk4_fp8(sc * s[4 * 33], sc * s[5 * 33], sc * s[6 * 33], sc * s[7 * 33]);
        o.z = pk4_fp8(sc * s[8 * 33], sc * s[9 * 33], sc * s[10 * 33], sc * s[11 * 33]); o.w = pk4_fp8(sc * s[12 * 33], sc * s[13 * 33], sc * s[14 * 33], sc * s[15 * 33]);
        *(u32x4*)(WT + (size_t)(drow0 + n) * K + k0 + 16 * c) = o; }
    LDS_WAIT(); asm volatile("" ::: "memory");
}
__device__ __forceinline__ int conv_mat8(const float* W, int K, int N, unsigned char* WT, int nb, size_t sstride, size_t dstride, int mode, float sc, LAS float* scr, int gw, int NGW, int rot, int lane) {
    const int nblk = N / 32, per = (K / 128) * nblk, total = per * nb;
    int start = gw - rot; if (start < 0) start += NGW;
    for (int it = start; it < total; it += NGW) {
        const int bi = it / per, r = it - bi * per, kb = r / nblk, nbk = r - kb * nblk, n0 = 32 * nbk;
        const int drow0 = mode == 0 ? n0 : ((n0 >> 7) * 256 + (n0 & 127) + (mode == 2 ? 128 : 0));
        transpose_item8(W + (size_t)bi * sstride, N, K, WT + (size_t)bi * dstride, 128 * kb, n0, drow0, sc, scr, lane);
    }
    return (rot + total) % NGW;
}
__device__ __forceinline__ void transpose_item_i8(const float* W, int N, int K, unsigned char* WT, int k0, int n0, int drow0, float sc, const float* gk, LAS float* scr, int lane) {
    { const int kr = lane >> 3, q4 = 4 * (lane & 7); f32x4 v[16]; float g[16];
#pragma unroll
      for (int i = 0; i < 16; ++i) { v[i] = *(const f32x4*)(W + (size_t)(k0 + 8 * i + kr) * N + n0 + q4); g[i] = gk ? gk[k0 + 8 * i + kr] * sc : sc; }
#pragma unroll
      for (int i = 0; i < 16; ++i) { LAS float* d = scr + (8 * i + kr) * 33 + q4; d[0] = v[i].x * g[i]; d[1] = v[i].y * g[i]; d[2] = v[i].z * g[i]; d[3] = v[i].w * g[i]; } }
    LDS_WAIT(); asm volatile("" ::: "memory");
    const int c = lane & 7;
#pragma unroll
    for (int j = 0; j < 4; ++j) { const int n = (lane >> 3) + 8 * j; const LAS float* s = scr + (16 * c) * 33 + n;
        u32x4 o; o.x = pk4_i8(s[0 * 33], s[1 * 33], s[2 * 33], s[3 * 33]); o.y = pk4_i8(s[4 * 33], s[5 * 33], s[6 * 33], s[7 * 33]);
        o.z = pk4_i8(s[8 * 33], s[9 * 33], s[10 * 33], s[11 * 33]); o.w = pk4_i8(s[12 * 33], s[13 * 33], s[14 * 33], s[15 * 33]);
        *(u32x4*)(WT + (size_t)(drow0 + n) * K + k0 + 16 * c) = o; }
    LDS_WAIT(); asm volatile("" ::: "memory");
}
__device__ __forceinline__ int conv_mat_i8(const float* W, int K, int N, unsigned char* WT, int mode, float sc, const float* gk, LAS float* scr, int gw, int NGW, int rot, int lane) {
    const int nblk = N / 32, total = (K / 128) * nblk;
    int start = gw - rot; if (start < 0) start += NGW;
    for (int it = start; it < total; it += NGW) {
        const int kb = it / nblk, nbk = it - kb * nblk, n0 = 32 * nbk;
        const int drow0 = mode == 0 ? n0 : ((n0 >> 7) * 256 + (n0 & 127) + (mode == 2 ? 128 : 0));
        transpose_item_i8(W, N, K, WT, 128 * kb, n0, drow0, sc, gk, scr, lane);
    }
    return (rot + total) % NGW;
}
__device__ __forceinline__ void absmax_mat(const float* W, int K, int N, const float* gk, unsigned* dst, int gt, int NGT, int lane) {
    float mx = 0.f; const int n4 = N / 4, tot = K * n4;
    for (int i0 = gt; i0 < tot; i0 += 8 * NGT) {
        f32x4 v[8]; float g[8];
#pragma unroll
        for (int u = 0; u < 8; ++u) { const int i = i0 + u * NGT; const bool ok = i < tot; v[u] = ok ? ((const f32x4*)W)[i] : (f32x4){0.f, 0.f, 0.f, 0.f}; g[u] = (ok && gk) ? fabsf(gk[i / n4]) : 1.f; }
#pragma unroll
        for (int u = 0; u < 8; ++u) mx = fmaxf(mx, fmaxf(fmaxf(fabsf(v[u].x), fabsf(v[u].y)), fmaxf(fabsf(v[u].z), fabsf(v[u].w))) * g[u]);
    }
    mx = wave_max(mx);
    if (lane == 0) __hip_atomic_fetch_max(dst, __float_as_uint(mx), __ATOMIC_RELAXED, __HIP_MEMORY_SCOPE_AGENT);
}
__device__ __forceinline__ int conv_mat(const float* W, int K, int N, bf16* WT, int nb, size_t sstride, size_t dstride, int mode, const float* gk, LAS float* scr, int gw, int NGW, int rot, int lane) {
    const int nblk = N / 32, per = (K / 64) * nblk, total = per * nb;
    int start = gw - rot; if (start < 0) start += NGW;
    for (int it = start; it < total; it += NGW) {
        const int bi = it / per, r = it - bi * per, kb = r / nblk, nbk = r - kb * nblk, n0 = 32 * nbk;
        const int drow0 = mode == 0 ? n0 : ((n0 >> 7) * 256 + (n0 & 127) + (mode == 2 ? 128 : 0));
        transpose_item(W + (size_t)bi * sstride, N, K, WT + (size_t)bi * dstride, 64 * kb, n0, drow0, gk ? gk + (size_t)bi * K : nullptr, scr, lane);
    }
    return (rot + total) % NGW;
}
__device__ __forceinline__ void p0_prologue(LAS unsigned char* lds, int vcu, int G, int wv) {
    OPAQUE_TID(); OPAQUE_U(vcu); OPAQUE_U(G);
    LAS float* scr = (LAS float*)(lds + wave * 17408);
    const int gw = vcu * NWAVES + wave, NGW = G * NWAVES;
    unsigned char* ws = arg_ws();
    int rot = 0;
    { const int gt0 = vcu * (NWAVES * 64) + tid, NGT0 = G * NWAVES * 64; unsigned* wm = (unsigned*)(ws + WS_CTL) + CW_WMAX;
      if (I8_INPROJ) { absmax_mat(arg_in(2), D, INC, arg_in(1), wm + 0, gt0, NGT0, lane); absmax_mat(arg_in(2) + (size_t)D * INC, D, INC, arg_in(1) + D, wm + 64, gt0, NGT0, lane); }
      if (I8_FFN1) { absmax_mat(arg_in(23), D, DFF, arg_in(22), wm + 128, gt0, NGT0, lane); absmax_mat(arg_in(24), D, DFF, arg_in(22), wm + 128, gt0, NGT0, lane); }
      if (I8_OUTPROJ) { absmax_mat(arg_in(21), D, D, nullptr, wm + 192, gt0, NGT0, lane); absmax_mat(arg_in(21) + (size_t)D * D, D, D, nullptr, wm + 256, gt0, NGT0, lane); } }
    if (F8_FFN2) rot = conv_mat8(arg_in(25), DFF, D, ws + WS_WD, 1, 0, 0, 0, (float)(1 << SC_WD8), scr, gw, NGW, rot, lane);
    else rot = conv_mat(arg_in(25), DFF, D, (bf16*)(ws + WS_WD), 1, 0, 0, 0, nullptr, scr, gw, NGW, rot, lane);
    if (!I8_INPROJ) rot = conv_mat(arg_in(2), D, INC, (bf16*)(ws + WS_WIN), 2, (size_t)D * INC, (size_t)INC * D, 0, arg_in(1), scr, gw, NGW, rot, lane);
    if (!I8_OUTPROJ) rot = conv_mat(arg_in(21), D, D, (bf16*)(ws + WS_WOUT), 2, (size_t)D * D, (size_t)D * D, 0, nullptr, scr, gw, NGW, rot, lane);
    if (!I8_FFN1) { rot = conv_mat(arg_in(23), D, DFF, (bf16*)(ws + WS_WGU), 1, 0, 0, 1, arg_in(22), scr, gw, NGW, rot, lane); rot = conv_mat(arg_in(24), D, DFF, (bf16*)(ws + WS_WGU), 1, 0, 0, 2, arg_in(22), scr, gw, NGW, rot, lane); }
    rot = conv_mat8(arg_in(27), D, DFE, ws + WS_MGU8, NE, (size_t)D * DFE, (size_t)2 * DFE * D, 1, (float)(1 << SC_WGU8), scr, gw, NGW, rot, lane);
    rot = conv_mat8(arg_in(28), D, DFE, ws + WS_MGU8, NE, (size_t)D * DFE, (size_t)2 * DFE * D, 2, (float)(1 << SC_WGU8), scr, gw, NGW, rot, lane);
    rot = conv_mat8(arg_in(29), DFE, D, ws + WS_MD8, NE, (size_t)DFE * D, (size_t)D * DFE, 0, (float)(1 << SC_WD8), scr, gw, NGW, rot, lane);
    const int gt = vcu * (NWAVES * 64) + tid, NGT = G * NWAVES * 64;
    { bf16* wm = (bf16*)(ws + WS_GWM); const float* src = arg_in(11);
      for (int i = gt; i < 2 * 4 * 128 * 128; i += NGT) { const int s = i & 127, t = (i >> 7) & 127; wm[i] = (bf16)(pk2(s <= t ? src[i] : 0.f, 0.f) & 0xffffu); } }
    { bf16* wat = (bf16*)(ws + WS_WAT); bf16* wxt = (bf16*)(ws + WS_WXT); const float* sa = arg_in(15); const float* sx = arg_in(17);
      for (int i = gt; i < 2 * 4 * 64 * 64; i += NGT) { const int ii = i & 63, j = (i >> 6) & 63, lh = i >> 12; const int si = (lh << 12) + ii * 64 + j;
          wat[i] = (bf16)(pk2(sa[si], 0.f) & 0xffffu); wxt[i] = (bf16)(pk2(sx[si], 0.f) & 0xffffu); } }
    { unsigned* xn8 = (unsigned*)(ws + WS_XN8 + (size_t)NTOK * D); for (int i = gt; i < D / 4; i += NGT) xn8[i] = 0u; }
    { const float* x0 = arg_in(0); bf16* xb = (bf16*)(ws + WS_XB); float* rd = (float*)(ws + WS_RD);
      for (int m0 = 4 * gw; m0 < NTOK; m0 += 4 * NGW) { f32x4 v[4][4];
#pragma unroll
          for (int r = 0; r < 4; ++r)
#pragma unroll
              for (int j = 0; j < 4; ++j) v[r][j] = ((const f32x4*)(x0 + (size_t)(m0 + r) * D) + lane)[64 * j];
#pragma unroll
          for (int r = 0; r < 4; ++r) { unsigned long long* o8 = (unsigned long long*)(xb + (size_t)(m0 + r) * D) + lane; float sq = 0.f;
#pragma unroll
              for (int j = 0; j < 4; ++j) { sq += (v[r][j].x * v[r][j].x + v[r][j].y * v[r][j].y) + (v[r][j].z * v[r][j].z + v[r][j].w * v[r][j].w);
                  o8[64 * j] = (unsigned long long)pk2(v[r][j].x, v[r][j].y) | ((unsigned long long)pk2(v[r][j].z, v[r][j].w) << 32); }
              sq = wave_sum(sq); if (lane == 0) rd[m0 + r] = __builtin_amdgcn_rsqf(sq * (1.f / D) + EPS); } } }
}
__device__ __forceinline__ void p1_weights_i8(LAS unsigned char* lds, int vcu, int G, int wv, bool proj, bool ffn) {
    OPAQUE_TID();
    LAS float* scr = (LAS float*)(lds + wave * 17408);
    const int gw = vcu * NWAVES + wave, NGW = G * NWAVES;
    unsigned char* ws = arg_ws(); const unsigned* wm = (const unsigned*)(ws + WS_CTL) + CW_WMAX;
    float sc[5];
#pragma unroll
    for (int t = 0; t < 5; ++t) { const float a = __uint_as_float(__hip_atomic_load(wm + 64 * t, RLX_AGENT)); sc[t] = a > 0.f ? 127.f / a : 0.f; }
    int rot = 0;
    if (I8_INPROJ && proj) { rot = conv_mat_i8(arg_in(2), D, INC, ws + WS_WIN, 0, sc[0], arg_in(1), scr, gw, NGW, rot, lane);
        rot = conv_mat_i8(arg_in(2) + (size_t)D * INC, D, INC, ws + WS_WIN + (size_t)INC * D, 0, sc[1], arg_in(1) + D, scr, gw, NGW, rot, lane); }
    if (I8_FFN1 && ffn) { rot = conv_mat_i8(arg_in(23), D, DFF, ws + WS_WGU, 1, sc[2], arg_in(22), scr, gw, NGW, rot, lane);
        rot = conv_mat_i8(arg_in(24), D, DFF, ws + WS_WGU, 2, sc[2], arg_in(22), scr, gw, NGW, rot, lane); }
    if (I8_OUTPROJ && proj) { rot = conv_mat_i8(arg_in(21), D, D, ws + WS_WOUT, 0, sc[3], nullptr, scr, gw, NGW, rot, lane);
        rot = conv_mat_i8(arg_in(21) + (size_t)D * D, D, D, ws + WS_WOUT + (size_t)D * D, 0, sc[4], nullptr, scr, gw, NGW, rot, lane); }
}
__device__ __forceinline__ float wscale(int t) { return __uint_as_float(__hip_atomic_load((const unsigned*)(arg_ws() + WS_CTL) + CW_WMAX + 64 * t, RLX_AGENT)) * (1.f / 127.f); }

__device__ __forceinline__ void rs_phase(int vcu, int G, int wv) {
    OPAQUE_TID(); OPAQUE_U(vcu); OPAQUE_U(G);
    const float* ss = (const float*)(arg_ws() + WS_SS); float* rd = (float*)(arg_ws() + WS_RD);
    for (int r = vcu * (NWAVES * 64) + tid; r < NTOK; r += G * NWAVES * 64) { const f32x4* p = (const f32x4*)(ss + (size_t)r * 16); const f32x4 a = p[0], b = p[1], c = p[2], d = p[3];
        const float t = (((a.x + a.y) + (a.z + a.w)) + ((b.x + b.y) + (b.z + b.w))) + (((c.x + c.y) + (c.z + c.w)) + ((d.x + d.y) + (d.z + d.w)));
        rd[r] = __builtin_amdgcn_rsqf(t * (1.f / D) + EPS); }
}
__device__ __forceinline__ void xq_phase(int vcu, int G, int wv) {
    OPAQUE_TID(); OPAQUE_U(vcu); OPAQUE_U(G);
    constexpr int XQR = 8;
    const int gw = vcu * NWAVES + wave, NGW = G * NWAVES;
    const bf16* xb = (const bf16*)(arg_ws() + WS_XB); unsigned char* xq = arg_ws() + WS_XQ; float* rs = (float*)(arg_ws() + WS_RS); float* rd = (float*)(arg_ws() + WS_RD);
    for (int m0 = XQR * gw; m0 < NTOK; m0 += XQR * NGW) {
        u32x2 b[XQR][4];
#pragma unroll
        for (int r = 0; r < XQR; ++r)
#pragma unroll
            for (int j = 0; j < 4; ++j) b[r][j] = ((const u32x2*)(xb + (size_t)(m0 + r) * D) + lane)[64 * j];
        float sq[XQR], mx[XQR];
#pragma unroll
        for (int r = 0; r < XQR; ++r) { sq[r] = 0.f; mx[r] = 0.f;
#pragma unroll
            for (int j = 0; j < 4; ++j) { const float x0 = bf_lo(b[r][j].x), x1 = bf_hi(b[r][j].x), x2 = bf_lo(b[r][j].y), x3 = bf_hi(b[r][j].y);
                sq[r] += (x0 * x0 + x1 * x1) + (x2 * x2 + x3 * x3); mx[r] = fmaxf(mx[r], fmaxf(fmaxf(fabsf(x0), fabsf(x1)), fmaxf(fabsf(x2), fabsf(x3)))); } }
#pragma unroll
        for (int r = 0; r < XQR; ++r) { sq[r] = wave_sum(sq[r]); mx[r] = wave_max(mx[r]); }
#pragma unroll
        for (int r = 0; r < XQR; ++r) { const float qs = mx[r] > 0.f ? 127.f / mx[r] : 0.f; unsigned* q4 = (unsigned*)(xq + (size_t)(m0 + r) * D) + lane;
#pragma unroll
            for (int j = 0; j < 4; ++j) q4[64 * j] = pk4_i8(bf_lo(b[r][j].x) * qs, bf_hi(b[r][j].x) * qs, bf_lo(b[r][j].y) * qs, bf_hi(b[r][j].y) * qs);
            if (lane == 0) { const float d = __builtin_amdgcn_rsqf(sq[r] * (1.f / D) + EPS); rs[m0 + r] = d * mx[r] * (1.f / 127.f); rd[m0 + r] = d; } }
    }
}
__device__ __forceinline__ void norm_router_phase(const float* g, const float* router, LAS unsigned char* lds, int G, int wv) {
    OPAQUE_TID(); OPAQUE_U(G);
    LAS int* lcnt = (LAS int*)(lds + 32768);
    LAS int* lbase = lcnt + 16;
    LAS int* rec_e = lcnt + 32;
    LAS int* rec_p = rec_e + 256;
    LAS float* rec_g = (LAS float*)(rec_p + 256);
    float Rr[4][8][4];
#pragma unroll
    for (int q = 0; q < 4; ++q)
#pragma unroll
        for (int c = 0; c < 4; ++c) { const f32x4* rp = (const f32x4*)(router + (size_t)(4 * lane + 256 * q + c) * NE); const f32x4 a = rp[0], b = rp[1];
            Rr[q][0][c] = a.x; Rr[q][1][c] = a.y; Rr[q][2][c] = a.z; Rr[q][3][c] = a.w; Rr[q][4][c] = b.x; Rr[q][5][c] = b.y; Rr[q][6][c] = b.z; Rr[q][7][c] = b.w; }
    gu32* ctl = (gu32*)(arg_ws() + WS_CTL);
    int* ltok = (int*)(arg_ws() + WS_LTOK); float* lgate = (float*)(arg_ws() + WS_LGATE);
    const bf16* xres = (const bf16*)(arg_ws() + WS_XB); unsigned char* xn8 = arg_ws() + WS_XN8;
    for (int ck = blockIdx.x; ck < NTOK / 128; ck += G) {
        if (tid < 16) lcnt[tid] = 0;
        __syncthreads();
        u32x2 nb[4];
#pragma unroll
        for (int q = 0; q < 4; ++q) nb[q] = ((const u32x2*)(xres + (size_t)(ck * 128 + wave * 16) * D) + lane)[64 * q];
        for (int j = 0; j < 16; ++j) {
            const int tl = wave * 16 + j, m = ck * 128 + tl;
            const f32x4* gr = (const f32x4*)g + lane;
            f32x4 v[4]; float s = 0.f;
#pragma unroll
            for (int q = 0; q < 4; ++q) { const u32x2 b = nb[q]; v[q] = (f32x4){bf_lo(b.x), bf_hi(b.x), bf_lo(b.y), bf_hi(b.y)}; s += (v[q].x * v[q].x + v[q].y * v[q].y) + (v[q].z * v[q].z + v[q].w * v[q].w); }
            if (j < 15) {
#pragma unroll
                for (int q = 0; q < 4; ++q) nb[q] = ((const u32x2*)(xres + (size_t)(m + 1) * D) + lane)[64 * q]; }
            const float rstd = __builtin_amdgcn_rsqf(wave_sum(s) * (1.f / D) + EPS);
            float lg[8];
#pragma unroll
            for (int e = 0; e < 8; ++e) lg[e] = 0.f;
            unsigned* o4 = (unsigned*)(xn8 + (size_t)m * D) + lane; const float s8 = (float)(1 << SC_XN8);
#pragma unroll
            for (int q = 0; q < 4; ++q) { const f32x4 gg = gr[64 * q]; f32x4 h; h.x = v[q].x * rstd * gg.x; h.y = v[q].y * rstd * gg.y; h.z = v[q].z * rstd * gg.z; h.w = v[q].w * rstd * gg.w;
                o4[64 * q] = pk4_fp8(s8 * h.x, s8 * h.y, s8 * h.z, s8 * h.w);
#pragma unroll
                for (int e = 0; e < 8; ++e) lg[e] += (h.x * Rr[q][e][0] + h.y * Rr[q][e][1]) + (h.z * Rr[q][e][2] + h.w * Rr[q][e][3]); }
#pragma unroll
            for (int e = 0; e < 8; ++e) lg[e] = wave_sum(lg[e]);
            int e0 = 0; float l0 = lg[0];
#pragma unroll
            for (int e = 1; e < 8; ++e) if (lg[e] > l0) { l0 = lg[e]; e0 = e; }
            int e1 = -1; float l1 = -INFINITY;
#pragma unroll
            for (int e = 0; e < 8; ++e) if (e != e0 && lg[e] > l1) { l1 = lg[e]; e1 = e; }
            if (lane == 0) { const float ex = __expf(l1 - l0); const float g0 = 1.f / (1.f + ex), g1 = ex / (1.f + ex);
                const int p0 = atomicAdd((int*)(lcnt + e0), 1), p1 = atomicAdd((int*)(lcnt + 8 + e1), 1);
                rec_e[2 * tl] = e0; rec_e[2 * tl + 1] = e1; rec_p[2 * tl] = p0; rec_p[2 * tl + 1] = p1; rec_g[2 * tl] = g0; rec_g[2 * tl + 1] = g1; }
        }
        __syncthreads();
        if (tid < 16) { const int c = lcnt[tid]; lbase[tid] = c ? (int)xb_add((unsigned*)(ctl + CW_MOECNT + 64 * tid), (unsigned)c) : 0; }
        __syncthreads();
        if (tid < 256) { const int tl = tid >> 1, k = tid & 1; const int e = rec_e[tid], li = k * 8 + e; const int pos = lbase[li] + rec_p[tid];
            ltok[(size_t)li * NTOK + pos] = ck * 128 + tl; lgate[(size_t)li * NTOK + pos] = rec_g[tid]; }
        __syncthreads();
    }
}

__device__ __forceinline__ void groupnorm_phase(const float* gg, int vcu, int G, int wv) {
    OPAQUE_TID(); OPAQUE_U(vcu); OPAQUE_U(G);
    const int gw = vcu * NWAVES + wave, NGW = G * NWAVES;
    f32x4 gv[4];
#pragma unroll
    for (int q = 0; q < 4; ++q) gv[q] = *(const f32x4*)(gg + 16 * lane + 4 * q);
    bf16* yb = (bf16*)(arg_ws() + WS_Y); unsigned char* yq = arg_ws() + WS_YQ; float* ysc = (float*)(arg_ws() + WS_YS);
    for (int m0 = 8 * gw; m0 < NTOK; m0 += 8 * NGW) {
        u32x4 w[8][2];
#pragma unroll
        for (int r = 0; r < 8; ++r) { const u32x4* p = (const u32x4*)(yb + (size_t)(m0 + r) * D + 16 * lane); w[r][0] = p[0]; w[r][1] = p[1]; }
#pragma unroll
        for (int r = 0; r < 8; ++r) {
            float v[16];
#pragma unroll
            for (int i = 0; i < 4; ++i) { v[2 * i] = bf_lo(w[r][0][i]); v[2 * i + 1] = bf_hi(w[r][0][i]); v[8 + 2 * i] = bf_lo(w[r][1][i]); v[8 + 2 * i + 1] = bf_hi(w[r][1][i]); }
            float s = 0.f;
#pragma unroll
            for (int i = 0; i < 16; ++i) s += v[i] * v[i];
            s += swz_xor<1>(s); s += swz_xor<2>(s); s += swz_xor<4>(s); s += swz_xor<8>(s);
            const float rstd = __builtin_amdgcn_rsqf(s * (1.f / 256.f) + EPS);
            float mx = 0.f;
#pragma unroll
            for (int i = 0; i < 16; ++i) { v[i] = v[i] * rstd * gv[i >> 2][i & 3]; mx = fmaxf(mx, fabsf(v[i])); }
            if (!I8_OUTPROJ) { u32x4 o0, o1;
#pragma unroll
                for (int i = 0; i < 4; ++i) { o0[i] = pk2(v[2 * i], v[2 * i + 1]); o1[i] = pk2(v[8 + 2 * i], v[8 + 2 * i + 1]); }
                u32x4* pw = (u32x4*)(yb + (size_t)(m0 + r) * D + 16 * lane); pw[0] = o0; pw[1] = o1; }
            else { mx = wave_max(mx); const float qs = mx > 0.f ? 127.f / mx : 0.f;
                u32x4 o; o.x = pk4_i8(v[0] * qs, v[1] * qs, v[2] * qs, v[3] * qs); o.y = pk4_i8(v[4] * qs, v[5] * qs, v[6] * qs, v[7] * qs);
                o.z = pk4_i8(v[8] * qs, v[9] * qs, v[10] * qs, v[11] * qs); o.w = pk4_i8(v[12] * qs, v[13] * qs, v[14] * qs, v[15] * qs);
                *(u32x4*)(yq + (size_t)(m0 + r) * D + 16 * lane) = o;
                if (lane == 0) ysc[m0 + r] = mx * (1.f / 127.f); }
        }
    }
}

constexpr int ATT_K_OFF = 0, ATT_KSTR = 144, ATT_V_OFF = 9216, ATT_VSTR = 136, ATT_DONE_OFF = 18432;
constexpr float ATT_THR = 40.0f;
__device__ __forceinline__ void attn_unit(int layer, int b, int h, int qb, LAS unsigned char* lds, int tid, int lane, int w) {
    const bf16* proj = (const bf16*)(arg_ws() + WS_PROJ);
    bf16* Y = (bf16*)(arg_ws() + WS_Y);
    const float* gq = arg_in(3) + layer * 64; const float* gk = arg_in(4) + layer * 64;
    const int r32 = lane & 31, hi = lane >> 5;
    const int tw0 = qb * 256 + 32 * w, tq = tw0 + r32;
    const size_t tokbase = (size_t)b * SEQ;
    bf16x8 qf[4];
    {
        const bf16* qrow = proj + (tokbase + tq) * INC + C_Q + h * 64 + 8 * hi;
        u32x4 raw[4]; float ss = 0.f;
#pragma unroll
        for (int kk = 0; kk < 4; ++kk) { raw[kk] = *(const u32x4*)(qrow + 16 * kk);
#pragma unroll
            for (int j = 0; j < 4; ++j) { const float x0 = bf_lo(raw[kk][j]), x1 = bf_hi(raw[kk][j]); ss += x0 * x0 + x1 * x1; } }
        ss = sum_halves(ss);
        const float sc = __builtin_amdgcn_rsqf(ss * (1.f / 64.f) + EPS) * (0.125f * LOG2E);
#pragma unroll
        for (int kk = 0; kk < 4; ++kk) { const f32x4 g0 = *(const f32x4*)(gq + 16 * kk + 8 * hi), g1 = *(const f32x4*)(gq + 16 * kk + 8 * hi + 4);
            u32x4 o; o.x = pk2(bf_lo(raw[kk].x) * sc * g0.x, bf_hi(raw[kk].x) * sc * g0.y); o.y = pk2(bf_lo(raw[kk].y) * sc * g0.z, bf_hi(raw[kk].y) * sc * g0.w);
            o.z = pk2(bf_lo(raw[kk].z) * sc * g1.x, bf_hi(raw[kk].z) * sc * g1.y); o.w = pk2(bf_lo(raw[kk].w) * sc * g1.z, bf_hi(raw[kk].w) * sc * g1.w);
            qf[kk] = __builtin_bit_cast(bf16x8, o); }
    }
    const int sr = tid >> 3, sc8 = tid & 7;
    const f32x4 gk0 = *(const f32x4*)(gk + 8 * sc8), gk1 = *(const f32x4*)(gk + 8 * sc8 + 4);
    f32x16 o0, o1;
#pragma unroll
    for (int i = 0; i < 16; ++i) { o0[i] = 0.f; o1[i] = 0.f; }
    float run = 0.f;
    LAS unsigned* done_cnt = (LAS unsigned*)(lds + ATT_DONE_OFF);
    bool wdone = false;
    if (tid == 0) *done_cnt = 0u;
    const int jt = 4 * qb + 3;
    u32x4 kraw, vraw;
    { const bf16* p = proj + (tokbase + 64 * jt + sr) * INC + h * 64 + 8 * sc8; kraw = *(const u32x4*)(p + C_K); vraw = *(const u32x4*)(p + C_V); }
    for (int j = jt; j >= 0; --j) {
        {
            float kv[8];
#pragma unroll
            for (int i = 0; i < 4; ++i) { kv[2 * i] = bf_lo(kraw[i]); kv[2 * i + 1] = bf_hi(kraw[i]); }
            float ss = 0.f;
#pragma unroll
            for (int i = 0; i < 8; ++i) ss += kv[i] * kv[i];
            ss += swz_xor<1>(ss); ss += swz_xor<2>(ss); ss += swz_xor<4>(ss);
            const float rs = __builtin_amdgcn_rsqf(ss * (1.f / 64.f) + EPS);
            u32x4 o; o.x = pk2(kv[0] * rs * gk0.x, kv[1] * rs * gk0.y); o.y = pk2(kv[2] * rs * gk0.z, kv[3] * rs * gk0.w); o.z = pk2(kv[4] * rs * gk1.x, kv[5] * rs * gk1.y); o.w = pk2(kv[6] * rs * gk1.z, kv[7] * rs * gk1.w);
            *(LAS u32x4*)(lds + ATT_K_OFF + sr * ATT_KSTR + sc8 * 16) = o;
#pragma unroll
            for (int i = 0; i < 8; ++i) *(LAS unsigned short*)(lds + ATT_V_OFF + (8 * sc8 + i) * ATT_VSTR + sr * 2) = (unsigned short)((vraw[i >> 1] >> (16 * (i & 1))) & 0xffffu);
        }
        __syncthreads();
        if (j > 0) { const bf16* p = proj + (tokbase + 64 * (j - 1) + sr) * INC + h * 64 + 8 * sc8; kraw = *(const u32x4*)(p + C_K); vraw = *(const u32x4*)(p + C_V); }
        if (!wdone && 64 * j <= tw0 + 30) {
            f32x16 p0, p1;
#pragma unroll
            for (int i = 0; i < 16; ++i) { p0[i] = 0.f; p1[i] = 0.f; }
#pragma unroll
            for (int kk = 0; kk < 4; ++kk) {
                const bf16x8 k0 = *(const LAS bf16x8*)(lds + ATT_K_OFF + r32 * ATT_KSTR + (16 * kk + 8 * hi) * 2);
                const bf16x8 k1 = *(const LAS bf16x8*)(lds + ATT_K_OFF + (32 + r32) * ATT_KSTR + (16 * kk + 8 * hi) * 2);
                p0 = __builtin_amdgcn_mfma_f32_32x32x16_bf16(k0, qf[kk], p0, 0, 0, 0);
                p1 = __builtin_amdgcn_mfma_f32_32x32x16_bf16(k1, qf[kk], p1, 0, 0, 0);
            }
            const bool diag = (64 * j + 63 >= tw0);
            if (diag) {
                const int lim = tq - 64 * j - 4 * hi;
#pragma unroll
                for (int r = 0; r < 16; ++r) { if ((r & 3) + 8 * (r >> 2) >= lim) p0[r] = -INFINITY; if (32 + (r & 3) + 8 * (r >> 2) >= lim) p1[r] = -INFINITY; } }
            float sp[2][16];
#pragma unroll
            for (int kb = 0; kb < 2; ++kb)
#pragma unroll
                for (int r = 0; r < 16; ++r) { const float z = kb ? p1[r] : p0[r];
                    float s = __builtin_amdgcn_logf(1.0f + __builtin_amdgcn_exp2f(z));
                    sp[kb][r] = s; }
            float Gt[2][4], Gh[2][4];
#pragma unroll
            for (int kb = 0; kb < 2; ++kb)
#pragma unroll
                for (int g = 0; g < 4; ++g) { const float gs = (sp[kb][4 * g] + sp[kb][4 * g + 1]) + (sp[kb][4 * g + 2] + sp[kb][4 * g + 3]); float lo, hh; halves(gs, lo, hh); Gt[kb][g] = lo + hh; Gh[kb][g] = hh; }
            float suf = run;
            u32x4 pw[4];
#pragma unroll
            for (int kb = 1; kb >= 0; --kb)
#pragma unroll
                for (int g = 3; g >= 0; --g) {
                    const float base = suf + (hi == 0 ? Gh[kb][g] : 0.f);
                    const float c3 = base + sp[kb][4 * g + 3], c2 = c3 + sp[kb][4 * g + 2], c1 = c2 + sp[kb][4 * g + 1], c0 = c1 + sp[kb][4 * g];
                    const float z0 = kb ? p1[4 * g] : p0[4 * g], z1 = kb ? p1[4 * g + 1] : p0[4 * g + 1], z2 = kb ? p1[4 * g + 2] : p0[4 * g + 2], z3 = kb ? p1[4 * g + 3] : p0[4 * g + 3];
                    float w0 = __builtin_amdgcn_exp2f(z0 - c0), w1 = __builtin_amdgcn_exp2f(z1 - c1), w2 = __builtin_amdgcn_exp2f(z2 - c2), w3 = __builtin_amdgcn_exp2f(z3 - c3);
                    const int ks = 2 * kb + (g >> 1);
                    if (g & 1) { pw[ks].z = pk2(w0, w1); pw[ks].w = pk2(w2, w3); } else { pw[ks].x = pk2(w0, w1); pw[ks].y = pk2(w2, w3); }
                    suf += Gt[kb][g];
                }
            run = suf;
            if (__all(run >= ATT_THR)) { wdone = true; if (lane == 0) atomicAdd((unsigned*)done_cnt, 1u); }
#pragma unroll
            for (int ks = 0; ks < 4; ++ks) {
                const bf16x8 pb = __builtin_bit_cast(bf16x8, pw[ks]);
#pragma unroll
                for (int db = 0; db < 2; ++db) {
                    const LAS unsigned char* vp = lds + ATT_V_OFF + (32 * db + r32) * ATT_VSTR + (16 * ks + 4 * hi) * 2;
                    const u32x2 lo = *(const LAS u32x2*)vp, hh = *(const LAS u32x2*)(vp + 16);
                    u32x4 av; av.x = lo.x; av.y = lo.y; av.z = hh.x; av.w = hh.y;
                    if (db == 0) o0 = __builtin_amdgcn_mfma_f32_32x32x16_bf16(__builtin_bit_cast(bf16x8, av), pb, o0, 0, 0, 0);
                    else o1 = __builtin_amdgcn_mfma_f32_32x32x16_bf16(__builtin_bit_cast(bf16x8, av), pb, o1, 0, 0, 0);
                }
            }
        }
        __syncthreads();
        if (*done_cnt == 8u) break;
    }
    __syncthreads();
    bf16* yrow = Y + (tokbase + tq) * D + h * 64 + 4 * hi;
#pragma unroll
    for (int g = 0; g < 4; ++g) {
        u32x2 s0; s0.x = pk2(o0[4 * g], o0[4 * g + 1]); s0.y = pk2(o0[4 * g + 2], o0[4 * g + 3]); *(u32x2*)(yrow + 8 * g) = s0;
        u32x2 s1; s1.x = pk2(o1[4 * g], o1[4 * g + 1]); s1.y = pk2(o1[4 * g + 2], o1[4 * g + 3]); *(u32x2*)(yrow + 32 + 8 * g) = s1;
    }
}
__device__ __forceinline__ void attn_phase(int layer, LAS unsigned char* lds, int G, int wv) {
    OPAQUE_TID(); OPAQUE_U(G); OPAQUE_U(layer);
    for (int i = blockIdx.x; i < 512; i += G) {
        const int idx = i < 256 ? i : 767 - i;
        const int qb = 7 - (idx >> 6), bh = idx & 63;
        attn_unit(layer, bh >> 2, bh & 3, qb, lds, tid, lane, wave);
    }
}

constexpr int CF_H_OFF = 0, CF_Y_OFF = 81920;
__device__ __forceinline__ void conf_unit(int layer, int b, int c, LAS unsigned char* lds, int tid, int lane, int w) {
    const bf16* proj = (const bf16*)(arg_ws() + WS_PROJ);
    bf16* Y = (bf16*)(arg_ws() + WS_Y);
    const size_t tokbase = (size_t)b * SEQ; const int t0 = 128 * c;
    const int cp = tid & 127, tg = tid >> 7;
    const float* cw = arg_in(5) + (size_t)layer * 31 * 256 + 2 * cp;
    float w0[31], w1[31];
#pragma unroll
    for (int k = 0; k < 31; ++k) { const f32x2 t = *(const f32x2*)(cw + k * 256); w0[k] = t.x; w1[k] = t.y; }
    const f32x2 cb = *(const f32x2*)(arg_in(6) + layer * 256 + 2 * cp);
    const f32x4 lg = *(const f32x4*)(arg_in(7) + layer * 256 + 4 * lane), lb = *(const f32x4*)(arg_in(8) + layer * 256 + 4 * lane);
    { const int cq = tid & 31, rr = tid >> 5;
      u32x4 vv[10], gg[10];
#pragma unroll
      for (int ps = 0; ps < 10; ++ps) { const int i = ps * 16 + rr, pos = t0 - 30 + i; vv[ps] = (u32x4){0u, 0u, 0u, 0u}; gg[ps] = vv[ps];
          if (i < 158 && pos >= 0) { const bf16* p = proj + (tokbase + pos) * INC + 8 * cq; vv[ps] = *(const u32x4*)(p + C_CV); gg[ps] = *(const u32x4*)(p + C_CG); } }
#pragma unroll
      for (int ps = 0; ps < 10; ++ps) { const int i = ps * 16 + rr; u32x4 o;
#pragma unroll
          for (int q = 0; q < 4; ++q) o[q] = pk2(bf_lo(vv[ps][q]) * fast_sigmoid(bf_lo(gg[ps][q])), bf_hi(vv[ps][q]) * fast_sigmoid(bf_hi(gg[ps][q])));
          if (i < 158) *(LAS u32x4*)(lds + CF_H_OFF + i * 512 + cq * 16) = o; } }
    __syncthreads();
    for (int ps = 0; ps < 4; ++ps) {
        const int tl0 = 32 * ps + 8 * tg;
        float a0[8], a1[8];
#pragma unroll
        for (int o = 0; o < 8; ++o) { a0[o] = cb.x; a1[o] = cb.y; }
#pragma unroll
        for (int q = 0; q < 38; ++q) { const unsigned dw = *(const LAS unsigned*)(lds + CF_H_OFF + (tl0 + q) * 512 + cp * 4); const float x0 = bf_lo(dw), x1 = bf_hi(dw);
#pragma unroll
            for (int o = 0; o < 8; ++o) { if (q - o >= 0 && q - o <= 30) { a0[o] += w0[q - o] * x0; a1[o] += w1[q - o] * x1; } } }
#pragma unroll
        for (int o = 0; o < 8; ++o) *(LAS f32x2*)(lds + CF_Y_OFF + ((8 * tg + o) * 256 + 2 * cp) * 4) = (f32x2){a0[o], a1[o]};
        __syncthreads();
#pragma unroll
        for (int r = 0; r < 4; ++r) { const int row = 4 * w + r; const f32x4 v = *(const LAS f32x4*)(lds + CF_Y_OFF + (row * 256 + 4 * lane) * 4);
            const float mean = wave_sum((v.x + v.y) + (v.z + v.w)) * (1.f / 256.f);
            const f32x4 d = v - mean; const float var = wave_sum((d.x * d.x + d.y * d.y) + (d.z * d.z + d.w * d.w)) * (1.f / 256.f);
            const float rstd = __builtin_amdgcn_rsqf(var + EPS);
            f32x4 y = d * rstd * lg + lb;
            y.x *= fast_sigmoid(y.x); y.y *= fast_sigmoid(y.y); y.z *= fast_sigmoid(y.z); y.w *= fast_sigmoid(y.w);
            u32x2 o; o.x = pk2(y.x, y.y); o.y = pk2(y.z, y.w);
            *(u32x2*)(Y + (tokbase + t0 + 32 * ps + row) * D + 256 + 4 * lane) = o; }
        __syncthreads();
    }
}
__device__ __forceinline__ void conf_phase(int layer, LAS unsigned char* lds, int G, int wv) {
    OPAQUE_TID(); OPAQUE_U(G); OPAQUE_U(layer);
    for (int i = blockIdx.x; i < 256; i += G) conf_unit(layer, i >> 4, i & 15, lds, tid, lane, wave);
}

constexpr int GM_U_OFF = 0, GM_USTR = 520, GM_V_OFF = 66560, GM_VSTR = 272;
__device__ __forceinline__ void gmlp_unit(int layer, int b, int c, LAS unsigned char* lds, int tid, int lane, int w) {
    const bf16* proj = (const bf16*)(arg_ws() + WS_PROJ);
    bf16* Y = (bf16*)(arg_ws() + WS_Y);
    const size_t tokbase = (size_t)b * SEQ; const int t0 = 128 * c;
    const f32x4 lg = *(const f32x4*)(arg_in(9) + layer * 256 + 4 * lane), lb = *(const f32x4*)(arg_in(10) + layer * 256 + 4 * lane);
    u32x2 urs[16], vrs[16];
#pragma unroll
    for (int j = 0; j < 16; ++j) { const bf16* p = proj + (tokbase + t0 + 16 * w + j) * INC + 4 * lane; urs[j] = *(const u32x2*)(p + C_GU); vrs[j] = *(const u32x2*)(p + C_GV); }
#pragma unroll
    for (int j = 0; j < 16; ++j) { const int t = 16 * w + j;
        const u32x2 ur = urs[j], vr = vrs[j];
        u32x2 uo; uo.x = pk2(gelu_tanh(bf_lo(ur.x)), gelu_tanh(bf_hi(ur.x))); uo.y = pk2(gelu_tanh(bf_lo(ur.y)), gelu_tanh(bf_hi(ur.y)));
        *(LAS u32x2*)(lds + GM_U_OFF + t * GM_USTR + lane * 8) = uo;
        f32x4 v; v.x = gelu_tanh(bf_lo(vr.x)); v.y = gelu_tanh(bf_hi(vr.x)); v.z = gelu_tanh(bf_lo(vr.y)); v.w = gelu_tanh(bf_hi(vr.y));
        const float mean = wave_sum((v.x + v.y) + (v.z + v.w)) * (1.f / 256.f);
        const f32x4 d = v - mean; const float var = wave_sum((d.x * d.x + d.y * d.y) + (d.z * d.z + d.w * d.w)) * (1.f / 256.f);
        const float rstd = __builtin_amdgcn_rsqf(var + EPS);
        const f32x4 y = d * rstd * lg + lb;
        const unsigned q0 = pk2(y.x, y.y), q1 = pk2(y.z, y.w);
        LAS unsigned char* vp = lds + GM_V_OFF + (4 * lane) * GM_VSTR + t * 2;
        *(LAS unsigned short*)(vp) = (unsigned short)(q0 & 0xffffu); *(LAS unsigned short*)(vp + GM_VSTR) = (unsigned short)(q0 >> 16);
        *(LAS unsigned short*)(vp + 2 * GM_VSTR) = (unsigned short)(q1 & 0xffffu); *(LAS unsigned short*)(vp + 3 * GM_VSTR) = (unsigned short)(q1 >> 16); }
    __syncthreads();
    const int fr = lane & 15, fq = lane >> 4, t = 16 * w + fr;
    const int nks = (w >> 1) + 1;
    const bf16* wm = (const bf16*)(arg_ws() + WS_GWM) + (size_t)layer * 4 * 128 * 128;
    const float* bs = arg_in(12) + layer * 4 * 128;
#pragma unroll
    for (int h = 0; h < 4; ++h) {
        bf16x8 bfr[4];
#pragma unroll
        for (int ks = 0; ks < 4; ++ks) { if (ks < nks) bfr[ks] = *(const bf16x8*)(wm + ((size_t)h * 128 + t) * 128 + 32 * ks + 8 * fq); else bfr[ks] = (bf16x8){0, 0, 0, 0, 0, 0, 0, 0}; }
        const float bsv = bs[h * 128 + t];
#pragma unroll
        for (int dt = 0; dt < 4; ++dt) {
            f32x4 acc = (f32x4){0.f, 0.f, 0.f, 0.f};
#pragma unroll
            for (int ks = 0; ks < 4; ++ks) { if (ks < nks) { const bf16x8 af = *(const LAS bf16x8*)(lds + GM_V_OFF + (64 * h + 16 * dt + fr) * GM_VSTR + (32 * ks + 8 * fq) * 2);
                    acc = __builtin_amdgcn_mfma_f32_16x16x32_bf16(af, bfr[ks], acc, 0, 0, 0); } }
            const u32x2 uu = *(const LAS u32x2*)(lds + GM_U_OFF + t * GM_USTR + (64 * h + 16 * dt + 4 * fq) * 2);
            u32x2 o; o.x = pk2(bf_lo(uu.x) * (acc[0] + bsv), bf_hi(uu.x) * (acc[1] + bsv)); o.y = pk2(bf_lo(uu.y) * (acc[2] + bsv), bf_hi(uu.y) * (acc[3] + bsv));
            *(u32x2*)(Y + (tokbase + t0 + t) * D + 512 + 64 * h + 16 * dt + 4 * fq) = o;
        }
    }
    __syncthreads();
}
__device__ __forceinline__ void gmlp_phase(int layer, LAS unsigned char* lds, int G, int wv) {
    OPAQUE_TID(); OPAQUE_U(G); OPAQUE_U(layer);
    for (int i = blockIdx.x; i < 256; i += G) gmlp_unit(layer, i >> 4, i & 15, lds, tid, lane, wave);
}

constexpr int LR_R0 = 0;
constexpr int LR_XB = 37376;
constexpr int LR_XF = 74240;
constexpr int LR_GT = 90624;
constexpr int LR_YO = 109056;
__device__ __forceinline__ int lr_sw(int t) { return t + (t >> 3); }
__device__ __forceinline__ void lru_unit(int layer, int b, int h, int qt, LAS unsigned char* lds, int tid, int lane, int w) {
    const bf16* proj = (const bf16*)(arg_ws() + WS_PROJ);
    bf16* Y = (bf16*)(arg_ws() + WS_Y);
    const size_t tokbase = (size_t)b * SEQ;
    const int chb = 64 * h;
    const int c8 = tid & 7, tr = tid >> 3;
    const int fr = lane & 15, fq = lane >> 4;
    float cwo[4][4], cbo[4];
    { const float* cwp = arg_in(13) + (size_t)layer * 4 * 256 + chb + 16 * qt + 4 * fq;
#pragma unroll
      for (int k = 0; k < 4; ++k) { const f32x4 x = *(const f32x4*)(cwp + k * 256); cwo[k][0] = x.x; cwo[k][1] = x.y; cwo[k][2] = x.z; cwo[k][3] = x.w; }
      const f32x4 y = *(const f32x4*)(arg_in(14) + layer * 256 + chb + 16 * qt + 4 * fq); cbo[0] = y.x; cbo[1] = y.y; cbo[2] = y.z; cbo[3] = y.w; }
    bf16x8 afa[4][2], afx[4][2];
    float pa = 0.f, px = 0.f;
    { const bf16* wat = (const bf16*)(arg_ws() + WS_WAT) + ((size_t)(layer * 4 + h) * 64 + 16 * qt + fr) * 64 + 8 * fq;
      const bf16* wxt = (const bf16*)(arg_ws() + WS_WXT) + ((size_t)(layer * 4 + h) * 64 + 16 * qt + fr) * 64 + 8 * fq;
#pragma unroll
      for (int ks = 0; ks < 2; ++ks) { const u32x4 ra = *(const u32x4*)(wat + 32 * ks), rx = *(const u32x4*)(wxt + 32 * ks);
          float fa[8], fx[8];
#pragma unroll
          for (int e = 0; e < 4; ++e) { fa[2 * e] = bf_lo(ra[e]); fa[2 * e + 1] = bf_hi(ra[e]); fx[2 * e] = bf_lo(rx[e]); fx[2 * e + 1] = bf_hi(rx[e]); }
          const float* cbp = arg_in(14) + layer * 256 + chb + 32 * ks + 8 * fq; const f32x4 c0 = *(const f32x4*)cbp, c1 = *(const f32x4*)(cbp + 4);
          pa += (fa[0] * c0.x + fa[1] * c0.y) + (fa[2] * c0.z + fa[3] * c0.w) + (fa[4] * c1.x + fa[5] * c1.y) + (fa[6] * c1.z + fa[7] * c1.w);
          px += (fx[0] * c0.x + fx[1] * c0.y) + (fx[2] * c0.z + fx[3] * c0.w) + (fx[4] * c1.x + fx[5] * c1.y) + (fx[6] * c1.z + fx[7] * c1.w);
#pragma unroll
          for (int k = 0; k < 4; ++k) { const float* cwp = arg_in(13) + (size_t)layer * 4 * 256 + k * 256 + chb + 32 * ks + 8 * fq; const f32x4 w0 = *(const f32x4*)cwp, w1 = *(const f32x4*)(cwp + 4);
              u32x4 oa, ox;
              oa.x = pk2(fa[0] * w0.x, fa[1] * w0.y); oa.y = pk2(fa[2] * w0.z, fa[3] * w0.w); oa.z = pk2(fa[4] * w1.x, fa[5] * w1.y); oa.w = pk2(fa[6] * w1.z, fa[7] * w1.w);
              ox.x = pk2(fx[0] * w0.x, fx[1] * w0.y); ox.y = pk2(fx[2] * w0.z, fx[3] * w0.w); ox.z = pk2(fx[4] * w1.x, fx[5] * w1.y); ox.w = pk2(fx[6] * w1.z, fx[7] * w1.w);
              afa[k][ks] = __builtin_bit_cast(bf16x8, oa); afx[k][ks] = __builtin_bit_cast(bf16x8, ox); } } }
    pa = sum_rows16(pa); pa = sum_halves(pa); px = sum_rows16(px); px = sum_halves(px);
    LAS float* bsh = (LAS float*)(lds + LR_YO);
    if (w == 0 && fq == 0) { bsh[fr] = pa; bsh[16 + fr] = px; }
    __syncthreads();
    float bav[4], bxv[4], clv[4];
    { const int ch = layer * 256 + chb + 16 * qt + 4 * fq; const f32x4 x0 = *(const f32x4*)(arg_in(16) + ch), x1 = *(const f32x4*)(arg_in(18) + ch), x2 = *(const f32x4*)(arg_in(19) + ch);
#pragma unroll
      for (int i = 0; i < 4; ++i) { bav[i] = x0[i] + bsh[4 * fq + i]; bxv[i] = x1[i] + bsh[16 + 4 * fq + i]; clv[i] = -8.0f * log1pf(expf(-x2[i])); } }
    const int sc = 2 * w + (lane >> 5), sg = lane & 31;
    float hc = 0.f;
    u32x4 xpre[5], gpre;
#define LR_FETCH(P0) do { _Pragma("unroll") for (int ps = 0; ps < 5; ++ps) { const int i = 64 * ps + tr; const int pos = (P0) - 3 + i; xpre[ps] = (u32x4){0u, 0u, 0u, 0u}; \
            if (i < 259 && pos >= 0) xpre[ps] = *(const u32x4*)(proj + (tokbase + pos) * INC + C_LX + chb + 8 * c8); } \
        gpre = *(const u32x4*)(proj + (tokbase + (P0) + (tid >> 1)) * INC + C_LG + chb + 16 * qt + 8 * (tid & 1)); } while (0)
    LR_FETCH(0);
    for (int it = 0; it < 8; ++it) {
        const int p0 = 256 * it;
#pragma unroll
        for (int ps = 0; ps < 5; ++ps) { const int i = 64 * ps + tr; if (i < 259) *(LAS u32x4*)(lds + LR_R0 + i * 144 + c8 * 16) = xpre[ps]; }
        { const int t = tid >> 1, hf = tid & 1; const u32x4 gr = gpre;
          LAS float* gt = (LAS float*)(lds + LR_GT) + lr_sw(t);
#pragma unroll
          for (int i = 0; i < 4; ++i) { gt[(8 * hf + 2 * i) * 288] = gelu_tanh(bf_lo(gr[i])); gt[(8 * hf + 2 * i + 1) * 288] = gelu_tanh(bf_hi(gr[i])); } }
        __syncthreads();
        if (it < 7) LR_FETCH(p0 + 256);
#pragma unroll
        for (int tt = 0; tt < 2; ++tt) { const int t = 32 * w + 16 * tt + fr;
            f32x4 ca = (f32x4){0.f, 0.f, 0.f, 0.f}, cx = (f32x4){0.f, 0.f, 0.f, 0.f};
            float xf[4];
#pragma unroll
            for (int i = 0; i < 4; ++i) xf[i] = cbo[i];
#pragma unroll
            for (int k = 0; k < 4; ++k) {
#pragma unroll
                for (int ks = 0; ks < 2; ++ks) { const bf16x8 bfr = *(const LAS bf16x8*)(lds + LR_R0 + (t + k) * 144 + (32 * ks + 8 * fq) * 2);
                    ca = __builtin_amdgcn_mfma_f32_16x16x32_bf16(afa[k][ks], bfr, ca, 0, 0, 0); cx = __builtin_amdgcn_mfma_f32_16x16x32_bf16(afx[k][ks], bfr, cx, 0, 0, 0); }
                const u32x2 r = *(const LAS u32x2*)(lds + LR_R0 + (t + k) * 144 + (16 * qt + 4 * fq) * 2);
                xf[0] += cwo[k][0] * bf_lo(r.x); xf[1] += cwo[k][1] * bf_hi(r.x); xf[2] += cwo[k][2] * bf_lo(r.y); xf[3] += cwo[k][3] * bf_hi(r.y); }
            LAS float* aa = (LAS float*)(lds + LR_XB) + lr_sw(t); LAS float* bb = (LAS float*)(lds + LR_XB + 18432) + lr_sw(t);
#pragma unroll
            for (int i = 0; i < 4; ++i) { const float r = fast_sigmoid(ca[i] + bav[i]), ig = fast_sigmoid(cx[i] + bxv[i]); const float la = r * clv[i];
                aa[(4 * fq + i) * 288] = __expf(la); bb[(4 * fq + i) * 288] = __builtin_amdgcn_sqrtf(one_minus_exp(2.0f * la)) * ig * xf[i]; } }
        __syncthreads();
        { const LAS float* aa = (const LAS float*)(lds + LR_XB) + sc * 288; const LAS float* bb = (const LAS float*)(lds + LR_XB + 18432) + sc * 288;
          const LAS float* gt = (const LAS float*)(lds + LR_GT) + sc * 288; LAS float* yo = (LAS float*)(lds + LR_YO) + sc * 288;
          float av[8], bv[8]; float A = 1.f, B = 0.f;
#pragma unroll
          for (int k = 0; k < 8; ++k) { av[k] = aa[9 * sg + k]; bv[k] = bb[9 * sg + k]; B = av[k] * B + bv[k]; A *= av[k]; }
#define LR_DPP(old, v, ctrl, rmask) __int_as_float(__builtin_amdgcn_update_dpp(__float_as_int(old), __float_as_int(v), ctrl, rmask, 0xf, false))
          { float Ap, Bp;
            Ap = LR_DPP(1.f, A, 0x111, 0xf); Bp = LR_DPP(0.f, B, 0x111, 0xf); B = A * Bp + B; A = Ap * A;
            Ap = LR_DPP(1.f, A, 0x112, 0xf); Bp = LR_DPP(0.f, B, 0x112, 0xf); B = A * Bp + B; A = Ap * A;
            Ap = LR_DPP(1.f, A, 0x114, 0xf); Bp = LR_DPP(0.f, B, 0x114, 0xf); B = A * Bp + B; A = Ap * A;
            Ap = LR_DPP(1.f, A, 0x118, 0xf); Bp = LR_DPP(0.f, B, 0x118, 0xf); B = A * Bp + B; A = Ap * A;
            Ap = LR_DPP(1.f, A, 0x142, 0xa); Bp = LR_DPP(0.f, B, 0x142, 0xa); B = A * Bp + B; A = Ap * A; }
          float Ae = LR_DPP(1.f, A, 0x138, 0xf), Be = LR_DPP(0.f, B, 0x138, 0xf); if (sg == 0) { Ae = 1.f; Be = 0.f; }
          float hcur = Ae * hc + Be;
#define LR_RDL(v, l) __int_as_float(__builtin_amdgcn_readlane(__float_as_int(v), l))
          const float At = (lane >> 5) ? LR_RDL(A, 63) : LR_RDL(A, 31), Bt = (lane >> 5) ? LR_RDL(B, 63) : LR_RDL(B, 31);
#undef LR_RDL
#undef LR_DPP
          hc = At * hc + Bt;
#pragma unroll
          for (int k = 0; k < 8; ++k) { hcur = av[k] * hcur + bv[k]; yo[9 * sg + k] = hcur * gt[9 * sg + k]; } }
        __syncthreads();
        { const int t = tid >> 1, hf = tid & 1; const LAS float* yo = (const LAS float*)(lds + LR_YO) + lr_sw(t) + (8 * hf) * 288;
          u32x4 o; o.x = pk2(yo[0], yo[288]); o.y = pk2(yo[2 * 288], yo[3 * 288]); o.z = pk2(yo[4 * 288], yo[5 * 288]); o.w = pk2(yo[6 * 288], yo[7 * 288]);
          *(u32x4*)(Y + (tokbase + p0 + t) * D + 768 + chb + 16 * qt + 8 * hf) = o; }
    }
    __syncthreads();
}
#undef LR_FETCH
__device__ __forceinline__ void lru_phase(int layer, LAS unsigned char* lds, int G, int wv) {
    OPAQUE_TID(); OPAQUE_U(G); OPAQUE_U(layer);
    for (int i = blockIdx.x; i < 256; i += G) lru_unit(layer, i >> 4, (i >> 2) & 3, i & 3, lds, tid, lane, wave);
}

constexpr int N_PHASES = 25;
__device__ __forceinline__ void moe_table(LAS unsigned char* lds, int wv) {
    OPAQUE_TID();
    LAS int* tab = (LAS int*)(lds + MOE_TAB);
    if (tid < 16) { gu32* ctl = (gu32*)(arg_ws() + WS_CTL); const int c = (int)__hip_atomic_load(ctl + CW_MOECNT + 64 * tid, RLX_AGENT); tab[tid] = c; tab[40 + tid] = (c + 255) >> 8; }
    __syncthreads();
    if (tid < 17) { int accu = 0; for (int j = 0; j < tid; ++j) accu += tab[40 + j]; tab[16 + tid] = accu; }
    __syncthreads();
}
__device__ __forceinline__ void moe_gather_phase(LAS unsigned char* lds, int vcu, int G, int wv) {
    OPAQUE_TID(); OPAQUE_U(vcu); OPAQUE_U(G);
    moe_table(lds, wv);
    const int gw = vcu * NWAVES + wave, NGW = G * NWAVES;
    const unsigned char* xn8 = arg_ws() + WS_XN8; unsigned char* xg = arg_ws() + WS_XG8; const int* ltok = (const int*)(arg_ws() + WS_LTOK);
    const LAS int* tab = (const LAS int*)(lds + MOE_TAB);
    const int nrows = tab[32] * 256;
    for (int r0 = 8 * gw; r0 < nrows; r0 += 8 * NGW) {
        const int pm = r0 >> 8; int se = 0;
#pragma unroll
        for (int j = 1; j < 16; ++j) se += (pm >= tab[16 + j]) ? 1 : 0;
        const int p0 = r0 - tab[16 + se] * 256, cnt = tab[se];
        int tok[8]; u32x4 v[8];
#pragma unroll
        for (int i = 0; i < 8; ++i) tok[i] = (p0 + i) < cnt ? ltok[(size_t)se * NTOK + p0 + i] : NTOK;
#pragma unroll
        for (int i = 0; i < 8; ++i) v[i] = *(const u32x4*)(xn8 + (size_t)tok[i] * D + 16 * lane);
#pragma unroll
        for (int i = 0; i < 8; ++i) *(u32x4*)(xg + (size_t)(r0 + i) * D + 16 * lane) = v[i];
    }
}
__global__ void __launch_bounds__(NWAVES * 64, 2) fwd_kernel(Args args) {
    extern __shared__ __attribute__((aligned(16))) unsigned char lds_raw[];
    LAS unsigned char* lds = (LAS unsigned char*)lds_raw;
    const int wv = __builtin_amdgcn_readfirstlane((int)threadIdx.x >> 6);
    const int G_ = gridDim.x; const int bx_ = blockIdx.x; const int vcu_ = (G_ % 8 == 0) ? (bx_ % 8) * (G_ / 8) + bx_ / 8 : bx_;
#define G opq_s(G_)
#define bx opq_s(bx_)
#define vcu opq_s(vcu_)
    gu32* ctl = (gu32*)(arg_ws() + WS_CTL);
    for (int u = threadIdx.x; u < (LDS_BYTES - LDSCTL_OFF) / 4; u += NWAVES * 64) ((LAS unsigned*)(lds + LDSCTL_OFF))[u] = 0u;
    __syncthreads();
#if !MK_MULTI
    (void)xcd_barrier_post((unsigned*)(ctl + CW_BAR), (volatile LAS unsigned*)(lds + LDSCTL_OFF), threadIdx.x == 0);
#define GRID_BAR() do { XcdBarrier b_; b_.bar = (unsigned*)((gu32*)(arg_ws() + WS_CTL) + CW_BAR); b_.x = xb_xcc_id(); b_.st = (volatile LAS unsigned*)(lds + LDSCTL_OFF); xcd_barrier(b_, wv == 0 && lane_id() == 0); } while (0)
#else
#define GRID_BAR() do { } while (0)
#endif
    const int lo = args.ph_lo, hi = args.ph_hi;
#ifndef SITE_MASK
#define SITE_MASK 0xFFFF
#endif
#define SITE(n) constexpr (((SITE_MASK) >> (n)) & 1)
#define IN(k) (opq_s(lo) <= (k) && (k) < opq_s(hi))
#define SEAM(k) do { if (IN(k) && IN((k) + 1)) GRID_BAR(); } while (0)
    if SITE(0) if (IN(0)) { p0_prologue(lds, vcu, G, wv); }
    SEAM(0);
    if SITE(0) if (IN(1)) { if (I8_INPROJ || I8_OUTPROJ) p1_weights_i8(lds, vcu, G, wv, true, false); }
    if (I8_INPROJ || I8_OUTPROJ) SEAM(1);
    for (int L = 0; L < 2; ++L) {
        const int pb = 2 + 11 * L;
        if SITE(1) if (IN(pb + 0)) {
#if I8_INPROJ
            pg8::DenseOrder S; S.init(arg_ws() + WS_XQ, arg_ws() + WS_WIN + (size_t)L * INC * D, NTOK, INC, D / 2, G, bx);
            pg8::EpiBf16 E{(bf16*)(arg_ws() + WS_PROJ), INC, (const float*)(arg_ws() + WS_RS), wscale(L)};
            pg8::gemm_phase<pg8::EpiBf16, pg8::DenseOrder, -1, -1, true>(lds, D / 2, S, E, wv);
#else
            pg8::DenseOrder S; S.init(arg_ws() + WS_XB, arg_ws() + WS_WIN + (size_t)L * INC * D * 2, NTOK, INC, D, G, bx);
            pg8::EpiBf16 E{(bf16*)(arg_ws() + WS_PROJ), INC, (const float*)(arg_ws() + WS_RD), 1.f};
            pg8::gemm_phase<pg8::EpiBf16, pg8::DenseOrder>(lds, D, S, E, wv);
#endif
        }
        SEAM(pb + 0);
        if SITE(2) if (IN(pb + 1)) { attn_phase(L, lds, G, wv); __syncthreads(); }
        if SITE(3) if (IN(pb + 2)) { conf_phase(L, lds, G, wv); __syncthreads(); }
        if SITE(4) if (IN(pb + 3)) { gmlp_phase(L, lds, G, wv); __syncthreads(); }
        if SITE(5) if (IN(pb + 4)) { lru_phase(L, lds, G, wv); __syncthreads(); }
        SEAM(pb + 4);
        if SITE(6) if (IN(pb + 5)) { groupnorm_phase(arg_in(20) + L * D, vcu, G, wv); if (I8_FFN1 && L == 0) { __syncthreads(); p1_weights_i8(lds, vcu, G, wv, false, true); } }
        SEAM(pb + 5);
        if (L == 0) {
            if SITE(7) if (IN(pb + 6)) {
#if I8_OUTPROJ
                pg8::DenseOrder S; S.init(arg_ws() + WS_YQ, arg_ws() + WS_WOUT, NTOK, D, D / 2, G, bx);
                pg8::EpiResB<true, true> E{arg_in(0), (bf16*)(arg_ws() + WS_XB), (const float*)(arg_ws() + WS_YS), wscale(3), nullptr};
                pg8::gemm_phase<pg8::EpiResB<true, true>, pg8::DenseOrder, -1, -1, true>(lds, D / 2, S, E, wv);
#else
                pg8::DenseOrder S; S.init(arg_ws() + WS_Y, arg_ws() + WS_WOUT, NTOK, D, D, G, bx);
                pg8::EpiResB<false, false, !I8_FFN1> E{nullptr, (bf16*)(arg_ws() + WS_XB), nullptr, 1.f, (float*)(arg_ws() + WS_SS)};
                pg8::gemm_phase<pg8::EpiResB<false, false, !I8_FFN1>, pg8::DenseOrder>(lds, D, S, E, wv);
#endif
            }
            SEAM(pb + 6);
            if SITE(8) if (IN(pb + 7)) { if (I8_FFN1) xq_phase(vcu, G, wv); else rs_phase(vcu, G, wv); }
            SEAM(pb + 7);
            if SITE(10) if (IN(pb + 8)) {
#if I8_FFN1
                pg8::DenseOrder S; S.init(arg_ws() + WS_XQ, arg_ws() + WS_WGU, NTOK, 2 * DFF, D / 2, G, bx);
#if F8_FFN2
                pg8::EpiSwiGLUF8 E{arg_ws() + WS_HID, DFF, (const float*)(arg_ws() + WS_RS), wscale(2)};
                pg8::gemm_phase<pg8::EpiSwiGLUF8, pg8::DenseOrder, -1, -1, true>(lds, D / 2, S, E, wv);
#else
                pg8::EpiSwiGLU E{(bf16*)(arg_ws() + WS_HID), DFF, (const float*)(arg_ws() + WS_RS), wscale(2)};
                pg8::gemm_phase<pg8::EpiSwiGLU, pg8::DenseOrder, -1, -1, true>(lds, D / 2, S, E, wv);
#endif
#else
                pg8::DenseOrder S; S.init(arg_ws() + WS_XB, arg_ws() + WS_WGU, NTOK, 2 * DFF, D, G, bx);
                pg8::EpiSwiGLU E{(bf16*)(arg_ws() + WS_HID), DFF, (const float*)(arg_ws() + WS_RD), 1.f};
                pg8::gemm_phase<pg8::EpiSwiGLU, pg8::DenseOrder>(lds, D, S, E, wv);
#endif
            }
            SEAM(pb + 8);
            if SITE(11) if (IN(pb + 9)) {
#if F8_FFN2
                pg8::DenseOrder S; S.init(arg_ws() + WS_HID, arg_ws() + WS_WD, NTOK, D, DFF / 2, G, bx);
                pg8::EpiResB<false, false, !I8_INPROJ> E{nullptr, (bf16*)(arg_ws() + WS_XB), nullptr, 1.f, (float*)(arg_ws() + WS_SS)};
                pg8::gemm_phase<pg8::EpiResB<false, false, !I8_INPROJ>, pg8::DenseOrder, 127 - SC_HID8, 127 - SC_WD8>(lds, DFF / 2, S, E, wv);
#else
                pg8::DenseOrder S; S.init(arg_ws() + WS_HID, arg_ws() + WS_WD, NTOK, D, DFF, G, bx);
                pg8::EpiResB<false, false, !I8_INPROJ> E{nullptr, (bf16*)(arg_ws() + WS_XB), nullptr, 1.f, (float*)(arg_ws() + WS_SS)};
                pg8::gemm_phase<pg8::EpiResB<false, false, !I8_INPROJ>, pg8::DenseOrder>(lds, DFF, S, E, wv);
#endif
            }
            SEAM(pb + 9);
            if SITE(8) if (IN(pb + 10)) { if (I8_INPROJ) xq_phase(vcu, G, wv); else rs_phase(vcu, G, wv); }
            SEAM(pb + 10);
        } else {
            if SITE(15) if (IN(pb + 6)) {
#if I8_OUTPROJ
                pg8::DenseOrder S; S.init(arg_ws() + WS_YQ, arg_ws() + WS_WOUT + (size_t)D * D, NTOK, D, D / 2, G, bx);
                pg8::EpiResB<false, true> E{nullptr, (bf16*)(arg_ws() + WS_XB), (const float*)(arg_ws() + WS_YS), wscale(4), nullptr};
                pg8::gemm_phase<pg8::EpiResB<false, true>, pg8::DenseOrder, -1, -1, true>(lds, D / 2, S, E, wv);
#else
                pg8::DenseOrder S; S.init(arg_ws() + WS_Y, arg_ws() + WS_WOUT + (size_t)D * D * 2, NTOK, D, D, G, bx);
                pg8::EpiResB<false, false> E{nullptr, (bf16*)(arg_ws() + WS_XB), nullptr, 1.f, nullptr};
                pg8::gemm_phase<pg8::EpiResB<false, false>, pg8::DenseOrder>(lds, D, S, E, wv);
#endif
            }
            SEAM(pb + 6);
            if SITE(9) if (IN(pb + 7)) norm_router_phase(arg_in(22) + D, arg_in(26), lds, G, wv);
            SEAM(pb + 7);
            if SITE(14) if (IN(pb + 8)) { moe_gather_phase(lds, vcu, G, wv); __syncthreads(); }
            SEAM(pb + 8);
#pragma clang loop unroll(disable)
            for (int st = 0; st < 3; ++st) {
                if (IN(pb + 9 + st)) {
                    moe_table(lds, wv);
                    int hv = 0;
                    if SITE(13) if (st >= 1) {
                        const int slot = st - 1;
                        pg8::MoeOrder<8> S; S.init(arg_ws() + WS_HID, arg_ws() + WS_MD8, (const LAS int*)(lds + MOE_TAB), 8 * slot, D / 256, (size_t)256 * DFE, (size_t)D * DFE, G, bx);
                        hv = (S.nM * S.nN) % G;
                        pg8::EpiMoeDown E{(const LAS int*)(lds + MOE_TAB), slot == 0};
                        pg8::gemm_phase<pg8::EpiMoeDown, pg8::MoeOrder<8>, 127 - SC_HID8, 127 - SC_WD8>(lds, DFE / 2, S, E, wv);
                    }
                    if SITE(12) if (st <= 1) {
                        pg8::MoeOrder<8> S; S.init(arg_ws() + WS_XG8, arg_ws() + WS_MGU8, (const LAS int*)(lds + MOE_TAB), 8 * st, 2 * DFE / 256, (size_t)256 * D, (size_t)2 * DFE * D, G, bx);
                        if (st == 1) { S.hv = hv; S.skip = 4; }
                        pg8::EpiSwiGLU8 E{arg_ws() + WS_HID, DFE};
                        pg8::gemm_phase<pg8::EpiSwiGLU8, pg8::MoeOrder<8>, 127 - SC_XN8, 127 - SC_WGU8>(lds, D / 2, S, E, wv);
                    }
                }
                if (st < 2) SEAM(pb + 9 + st);
            }
        }
    }
#undef IN
#undef G
#undef bx
#undef vcu
#undef SEAM
}

extern "C" void kernel_launch(void* const* d_in, const int* in_sizes, int n_in, void* d_out, int out_size, void* d_ws, size_t ws_size, hipStream_t stream) {
    static int grid = 0;
    if (grid == 0) {
        if (n_in != 30 || in_sizes[0] != NTOK * D || out_size != NTOK * D || ws_size < WS_END) { fprintf(stderr, "kernel_launch: unexpected shapes (n_in %d, ws %zu)\n", n_in, ws_size); grid = -1; return; }
        int dev = 0, cus = 0, per_cu = 0;
        if (hipGetDevice(&dev) != hipSuccess || hipDeviceGetAttribute(&cus, hipDeviceAttributeMultiprocessorCount, dev) != hipSuccess) { grid = -1; return; }
        if (hipFuncSetAttribute((const void*)fwd_kernel, hipFuncAttributeMaxDynamicSharedMemorySize, LDS_BYTES) != hipSuccess) { fprintf(stderr, "kernel_launch: hipFuncSetAttribute failed\n"); grid = -1; return; }
        if (hipOccupancyMaxActiveBlocksPerMultiprocessor(&per_cu, (const void*)fwd_kernel, NWAVES * 64, LDS_BYTES) != hipSuccess || per_cu < 1) fprintf(stderr, "kernel_launch: occupancy query reports %d\n", per_cu);
        (void)hipGetLastError();
        grid = cus;
    }
    if (grid < 0) return;
    if (hipMemsetAsync((char*)d_ws + WS_CTL, 0, CTL_ZERO_BYTES, stream) != hipSuccess) return;
    Args a{};
    for (int i = 0; i < 30; ++i) a.in[i] = (const float*)d_in[i];
    a.out = (float*)d_out; a.ws = (unsigned char*)d_ws;
#if MK_MULTI
    for (int p = 0; p < N_PHASES; ++p) for (int r = ((PROBE_MASK >> p) & 1) ? 2 : 1; r > 0; --r) { a.ph_lo = p; a.ph_hi = p + 1; hipLaunchKernelGGL(fwd_kernel, dim3(grid), dim3(NWAVES * 64), LDS_BYTES, stream, a); }
#else
    a.ph_lo = 0; a.ph_hi = N_PHASES;
    hipLaunchKernelGGL(fwd_kernel, dim3(grid), dim3(NWAVES * 64), LDS_BYTES, stream, a);
#endif
}
```
